# Optimizing an MI355X kernel written in HIP

```python
import math
import jax, jax.numpy as jnp
from jax import lax
import numpy as np

D_MODEL = 1024
BATCH = 8
SEQ = 2048
DEPTH = 4
DEC_BATCH = 8
DEC_SEQ = 16
PAST_LEN = 4096

CHUNK = 64
Q_BLOCK = 128
HD_A = 64
H_A = D_MODEL // (2 * HD_A)
DH_B = 64
H_B = D_MODEL // (4 * DH_B)
W_A = H_A * HD_A
W_B = H_B * 2 * DH_B
D_FF = -(-8 * D_MODEL // (3 * 256)) * 256
PLE_DIM = 256
IN_SPLITS = (W_A, W_A, W_A, H_A, W_B, W_B, W_B, D_MODEL, D_MODEL)
IN_COLS = 3 * W_A + H_A + 3 * W_B + 2 * D_MODEL
ALPHA = (2 * DEPTH) ** 0.25
BETA = (8 * DEPTH) ** -0.25
LN_EPS = 1e-5
RMS_EPS = 1e-5
NEG_INF = -1e30

kernel_name = 'fox_diff_hybrid_stream_encoder'


def _split_cols(a, sizes):
    offs = []
    acc = 0
    for s in sizes[:-1]:
        acc += s
        offs.append(acc)
    return jnp.split(a, offs, axis=-1)


def _layer_norm(x, g, b):
    xf = x.astype(jnp.float32)
    mu = jnp.mean(xf, axis=-1, keepdims=True)
    xc = xf - mu
    var = jnp.mean(xc * xc, axis=-1, keepdims=True)
    y = xc * lax.rsqrt(var + LN_EPS) * g.astype(jnp.float32) + b.astype(jnp.float32)
    return y.astype(x.dtype)


def _sweep_queries(block_fn, q_arrays, q_pos):
    t_q = q_pos.shape[0]
    if t_q <= Q_BLOCK:
        return block_fn(q_arrays, q_pos)
    n_blk = t_q // Q_BLOCK
    blocked = tuple(jnp.moveaxis(a.reshape(a.shape[:1] + (n_blk, Q_BLOCK) + a.shape[2:]), 1, 0)
                    for a in q_arrays)
    out = lax.map(lambda xs: block_fn(xs[0], xs[1]), (blocked, q_pos.reshape(n_blk, Q_BLOCK)))
    out = jnp.moveaxis(out, 0, 1)
    return out.reshape(out.shape[:1] + (t_q,) + out.shape[3:])


def _fox_attention(q, k, v, c_q, c_k, q_pos, k_pos):
    scale = HD_A ** -0.5
    c_k_t = jnp.swapaxes(c_k, 1, 2)[:, :, None, :]

    def block(qa, qp):
        qb, cq = qa
        s = jnp.einsum('bqhd,bkhd->bhqk', qb, k).astype(jnp.float32) * scale
        s = s + jnp.swapaxes(cq, 1, 2)[..., None] - c_k_t
        mask = k_pos[None, :] <= qp[:, None]
        s = jnp.where(mask, s, NEG_INF)
        p = jax.nn.softmax(s, axis=-1)
        return jnp.einsum('bhqk,bkhd->bqhd', p.astype(v.dtype), v)

    return _sweep_queries(block, (q, c_q), q_pos)


def _diff_attention(q, k, v, lam, q_pos, k_pos):
    scale = DH_B ** -0.5
    slopes = 2.0 ** (-8.0 * jnp.arange(1, H_B + 1, dtype=jnp.float32) / H_B)
    k_chunk = k_pos // CHUNK

    def block(qa, qp):
        (qb,) = qa
        s = jnp.einsum('bqhcd,bkhcd->bchqk', qb, k).astype(jnp.float32) * scale
        dist = jnp.abs(qp[:, None] - k_pos[None, :]).astype(jnp.float32)
        s = s - slopes[:, None, None] * dist[None]
        mask = k_chunk[None, :] <= (qp // CHUNK)[:, None]
        s = jnp.where(mask, s, NEG_INF)
        p = jax.nn.softmax(s, axis=-1)
        a = p[:, 0] - lam * p[:, 1]
        return jnp.einsum('bhqk,bkhe->bqhe', a.astype(v.dtype), v)

    return _sweep_queries(block, (q,), q_pos)


def _hybrid_layer(x, p, past, q_pos, k_pos, lambda_init,
                  w_in, b_f, lq1, lk1, lq2, lk2, g_diff, w_ba, w_bb, w_o, ln1_g, ln1_b,
                  w_g, w_u, w_d, w_pg, w_pp, ln2_g, ln2_b):
    bsz, t, _ = x.shape
    proj = x @ w_in
    qa, ka, va, fa, qb, kb, vb, ga, gb = _split_cols(proj, IN_SPLITS)
    qa = qa.reshape(bsz, t, H_A, HD_A)
    ka = ka.reshape(bsz, t, H_A, HD_A)
    va = va.reshape(bsz, t, H_A, HD_A)
    logf = jax.nn.log_sigmoid((fa + b_f).astype(jnp.float32))
    qb = qb.reshape(bsz, t, H_B, 2, DH_B)
    kb = kb.reshape(bsz, t, H_B, 2, DH_B)
    vb = vb.reshape(bsz, t, H_B, 2 * DH_B)

    if past is None:
        ka_all, va_all, logf_all, kb_all, vb_all = ka, va, logf, kb, vb
    else:
        pk, pv, plf, pkb, pvb = past
        ka_all = jnp.concatenate([pk, ka], axis=1)
        va_all = jnp.concatenate([pv, va], axis=1)
        logf_all = jnp.concatenate([plf.astype(jnp.float32), logf], axis=1)
        kb_all = jnp.concatenate([pkb, kb], axis=1)
        vb_all = jnp.concatenate([pvb, vb], axis=1)

    c_all = jnp.cumsum(logf_all, axis=1)
    c_q = c_all[:, -t:]
    oa = _fox_attention(qa, ka_all, va_all, c_q, c_all, q_pos, k_pos)

    f32 = jnp.float32
    lam = (jnp.exp(jnp.sum(lq1.astype(f32) * lk1.astype(f32)))
           - jnp.exp(jnp.sum(lq2.astype(f32) * lk2.astype(f32))) + lambda_init)
    ob = _diff_attention(qb, kb_all, vb_all, lam, q_pos, k_pos).astype(f32)
    ob = ob * lax.rsqrt(jnp.mean(ob * ob, axis=-1, keepdims=True) + RMS_EPS)
    ob = (ob * g_diff.astype(f32).reshape(H_B, 2 * DH_B) * (1.0 - lambda_init)).astype(x.dtype)

    merged = (jax.nn.sigmoid(ga) * (oa.reshape(bsz, t, W_A) @ w_ba)
              + jax.nn.sigmoid(gb) * (ob.reshape(bsz, t, W_B) @ w_bb))
    x = _layer_norm(ALPHA * x + merged @ w_o, ln1_g, ln1_b)

    ffn = (jax.nn.silu(x @ w_g) * (x @ w_u)) @ w_d
    ple = jax.nn.sigmoid(x @ w_pg) * (p @ w_pp)
    x = _layer_norm(ALPHA * x + ffn + ple, ln2_g, ln2_b)
    return x, (ka, va, logf, kb, vb)


def setup_inputs(seed: int = 0) -> dict:
    key = jax.random.key(seed)
    ks = jax.random.split(key, 32)
    f32 = jnp.float32
    nrm = lambda k, shape, s: jax.random.normal(k, shape, f32) * s
    return {
        'x_prompt': nrm(ks[0], (BATCH, SEQ, D_MODEL), 1.0),
        'x_sample': nrm(ks[1], (DEC_BATCH, DEC_SEQ, D_MODEL), 1.0),
        'p_prompt': nrm(ks[2], (DEPTH, BATCH, SEQ, PLE_DIM), 1.0),
        'p_sample': nrm(ks[3], (DEPTH, DEC_BATCH, DEC_SEQ, PLE_DIM), 1.0),
        'cache_fox_k': nrm(ks[4], (DEPTH, DEC_BATCH, PAST_LEN, H_A, HD_A), 1.0),
        'cache_fox_v': nrm(ks[5], (DEPTH, DEC_BATCH, PAST_LEN, H_A, HD_A), 1.0),
        'cache_fox_logf': jax.nn.log_sigmoid(
            jax.random.uniform(ks[6], (DEPTH, DEC_BATCH, PAST_LEN, H_A), f32, 1.0, 4.0)),
        'cache_diff_k': nrm(ks[7], (DEPTH, DEC_BATCH, PAST_LEN, H_B, 2, DH_B), 1.0),
        'cache_diff_v': nrm(ks[8], (DEPTH, DEC_BATCH, PAST_LEN, H_B, 2 * DH_B), 1.0),
        'w_in': nrm(ks[9], (DEPTH, D_MODEL, IN_COLS), D_MODEL ** -0.5),
        'b_forget': jax.random.uniform(ks[10], (DEPTH, H_A), f32, 1.0, 4.0),
        'lambda_q1': nrm(ks[11], (DEPTH, DH_B), 0.1),
        'lambda_k1': nrm(ks[12], (DEPTH, DH_B), 0.1),
        'lambda_q2': nrm(ks[13], (DEPTH, DH_B), 0.1),
        'lambda_k2': nrm(ks[14], (DEPTH, DH_B), 0.1),
        'diff_norm_g': 1.0 + nrm(ks[15], (DEPTH, W_B), 0.02),
        'w_branch_fox': nrm(ks[16], (DEPTH, W_A, D_MODEL), BETA * W_A ** -0.5),
        'w_branch_diff': nrm(ks[17], (DEPTH, W_B, D_MODEL), BETA * W_B ** -0.5),
        'w_out': nrm(ks[18], (DEPTH, D_MODEL, D_MODEL), BETA * D_MODEL ** -0.5),
        'ln1_g': 1.0 + nrm(ks[19], (DEPTH, D_MODEL), 0.02),
        'ln1_b': nrm(ks[20], (DEPTH, D_MODEL), 0.02),
        'w_ffn_gate': nrm(ks[21], (DEPTH, D_MODEL, D_FF), D_MODEL ** -0.5),
        'w_ffn_up': nrm(ks[22], (DEPTH, D_MODEL, D_FF), D_MODEL ** -0.5),
        'w_ffn_down': nrm(ks[23], (DEPTH, D_FF, D_MODEL), BETA * D_FF ** -0.5),
        'w_ple_gate': nrm(ks[24], (DEPTH, D_MODEL, D_MODEL), D_MODEL ** -0.5),
        'w_ple_proj': nrm(ks[25], (DEPTH, PLE_DIM, D_MODEL), BETA * PLE_DIM ** -0.5),
        'ln2_g': 1.0 + nrm(ks[26], (DEPTH, D_MODEL), 0.02),
        'ln2_b': nrm(ks[27], (DEPTH, D_MODEL), 0.02),
    }


def reference(x_prompt, x_sample, p_prompt, p_sample, cache_fox_k, cache_fox_v, cache_fox_logf,
              cache_diff_k, cache_diff_v, w_in, b_forget, lambda_q1, lambda_k1, lambda_q2, lambda_k2,
              diff_norm_g, w_branch_fox, w_branch_diff, w_out, ln1_g, ln1_b, w_ffn_gate, w_ffn_up,
              w_ffn_down, w_ple_gate, w_ple_proj, ln2_g, ln2_b):
    t_p = x_prompt.shape[1]
    t_s = x_sample.shape[1]
    past_len = cache_fox_k.shape[2]
    pos_p = jnp.arange(t_p, dtype=jnp.int32)
    q_pos_s = past_len + jnp.arange(t_s, dtype=jnp.int32)
    k_pos_s = jnp.arange(past_len + t_s, dtype=jnp.int32)

    hp, hs = x_prompt, x_sample
    new_p = ([], [], [], [], [])
    new_s = ([], [], [], [], [])
    for l in range(DEPTH):
        lambda_init = 0.8 - 0.6 * math.exp(-0.3 * l)
        lw = (w_in[l], b_forget[l], lambda_q1[l], lambda_k1[l], lambda_q2[l], lambda_k2[l],
              diff_norm_g[l], w_branch_fox[l], w_branch_diff[l], w_out[l], ln1_g[l], ln1_b[l],
              w_ffn_gate[l], w_ffn_up[l], w_ffn_down[l], w_ple_gate[l], w_ple_proj[l],
              ln2_g[l], ln2_b[l])
        hp, rows_p = _hybrid_layer(hp, p_prompt[l], None, pos_p, pos_p, lambda_init, *lw)
        past = (cache_fox_k[l], cache_fox_v[l], cache_fox_logf[l], cache_diff_k[l], cache_diff_v[l])
        hs, rows_s = _hybrid_layer(hs, p_sample[l], past, q_pos_s, k_pos_s, lambda_init, *lw)
        for lst, r in zip(new_p, rows_p):
            lst.append(r)
        for lst, r in zip(new_s, rows_s):
            lst.append(r)

    fox_k_p, fox_v_p, fox_lf_p, diff_k_p, diff_v_p = [jnp.stack(a) for a in new_p]
    fox_k_s, fox_v_s, fox_lf_s, diff_k_s, diff_v_s = [jnp.stack(a) for a in new_s]
    return (hp, hs, fox_k_p, fox_v_p, fox_lf_p, diff_k_p, diff_v_p,
            fox_k_s, fox_v_s, fox_lf_s, diff_k_s, diff_v_s)
```

```cpp
#include <hip/hip_runtime.h>
#include <hip/hip_bf16.h>
#include <cstdio>
#include <cstdint>
#include <cmath>
namespace pg8 {
#define PG8_LAS __attribute__((address_space(3)))
typedef unsigned short bf16_t;
typedef short bf16x8 __attribute__((ext_vector_type(8)));
typedef float f32x4 __attribute__((ext_vector_type(4)));
typedef unsigned u32x4 __attribute__((ext_vector_type(4)));
constexpr int BM = 256, BK = 64, HALF = 128, HTB = HALF * BK * 2  , STAGE_BYTES = 8 * HTB, NXCD = 8, WGM = 8;

__host__ __device__ __forceinline__ int lds_byte(int r, int c) { const int st = (r >> 4) * 2 + (c >> 5), rr = r & 15, cc = c & 31, ob = rr * 64 + cc * 2; return st * 1024 + (ob ^ (((ob >> 9) & 1) << 5)); }
__host__ __device__ __forceinline__ void stage_rc(int b, int& R, int& C) { const int st = b / 1024, sb = b % 1024, swz = sb ^ (((sb >> 9) & 1) << 5); R = (st >> 1) * 16 + swz / 64; C = (st & 1) * 32 + (swz % 64) / 2; }
__host__ __device__ __forceinline__ int perm32(int rho) { const int n = rho >> 4, i = rho & 15; return 8 * (i >> 2) + 4 * n + (i & 3); }

struct Unit { int pm, pn; };
struct Gemm { const bf16_t* A; const bf16_t* Bt; int M, N, K; };

struct StaticOrder {
    int nM, nN, nwg, G, c;
    __host__ __device__ void init(int M, int N, int G_, int c_) { nM = M / BM; nN = N / BM; nwg = nM * nN; G = G_; c = c_; }
    __host__ __device__ bool next(int i, Unit& u) const {
        const long L = (long)i * G + c; if (L >= nwg) return false;
        int wgid = (int)L; { const int q = nwg / NXCD, r = nwg % NXCD, xcd = wgid % NXCD, off = wgid / NXCD; wgid = (xcd < r ? xcd * (q + 1) : r * (q + 1) + (xcd - r) * q) + off; }
        const int nig = WGM * nN, gid = wgid / nig, fm = gid * WGM, gsz = (nM - fm) < WGM ? (nM - fm) : WGM;
        u.pm = fm + ((wgid % nig) % gsz); u.pn = (wgid % nig) / gsz; return true;
    }
    __device__ __forceinline__ void a_ready(const Unit&) const {}
    __device__ __forceinline__ void done(const Unit&) const {}
};

__device__ __forceinline__ unsigned cvt_pk_bf16(float lo, float hi) { unsigned r; asm volatile("v_cvt_pk_bf16_f32 %0, %1, %2" : "=v"(r) : "v"(lo), "v"(hi)); return r; }
typedef float f32x2 __attribute__((ext_vector_type(2)));
__device__ __forceinline__ f32x2 gelu_pk(f32x2 v) {
    const f32x2 av = __builtin_elementwise_abs(v), d = av * 0.2316418882f + 1.0f;
    f32x2 t; t.x = __builtin_amdgcn_rcpf(d.x); t.y = __builtin_amdgcn_rcpf(d.y);
    f32x2 q = t * 0.5307027145f + (-0.7265760135f); q = q * t + 0.7107068705f; q = q * t + (-0.142248368f); q = q * t + 0.127414796f; q = q * t;
    const f32x2 s = (v * v) * (-0.72134752044f);
    f32x2 e; e.x = __builtin_amdgcn_exp2f(s.x); e.y = __builtin_amdgcn_exp2f(s.y);
    const f32x2 m = v * (q * e), r = v - m;
    f32x2 o; o.x = v.x < 0.f ? m.x : r.x; o.y = v.y < 0.f ? m.y : r.y; return o;
}

template <int ACT  > struct EpiBf16 {
    static constexpr bool PERM = true, AFTER_DRAIN = false; static_assert(ACT == 0 || ACT == 1, "EpiBf16: ACT is 0 (none) or 1 (gelu_pk)");
    bf16_t* O; int ldc; const float* bias; int split_cols; size_t split_stride; float scale0;
    __device__ __forceinline__ void operator()(const f32x4 (&acc)[2][2][4][2], const Unit& u, int wr, int wc, int fr, int fq) const {
        const int row0 = u.pm * BM + wr * 64 + fr; int colt = u.pn * BM; bf16_t* base = O;
        float sc = 1.f; if (split_cols) { const int t = colt / split_cols; base += (size_t)t * split_stride; colt -= t * split_cols; if (t == 0) sc = scale0; }
        const int col0 = colt + wc * 32 + 8 * fq, bcol0 = u.pn * BM + wc * 32 + 8 * fq;
        f32x4 bv[2][2];
#pragma unroll
        for (int bj = 0; bj < 2; ++bj)
#pragma unroll
            for (int n = 0; n < 2; ++n) bv[bj][n] = bias ? *(const f32x4*)(bias + bcol0 + bj * HALF + 4 * n) : (f32x4){0.f, 0.f, 0.f, 0.f};
#pragma unroll
        for (int ai = 0; ai < 2; ++ai)
#pragma unroll
            for (int m = 0; m < 4; ++m) { bf16_t* rowp = base + (size_t)(row0 + ai * HALF + m * 16) * ldc + col0;
#pragma unroll
                for (int bj = 0; bj < 2; ++bj) { f32x4 v0 = acc[ai][bj][m][0] + bv[bj][0], v1 = acc[ai][bj][m][1] + bv[bj][1];
                    if (ACT == 1) { f32x2 a = gelu_pk((f32x2){v0[0], v0[1]}), b = gelu_pk((f32x2){v0[2], v0[3]}), c = gelu_pk((f32x2){v1[0], v1[1]}), d = gelu_pk((f32x2){v1[2], v1[3]});
                        v0 = (f32x4){a.x, a.y, b.x, b.y}; v1 = (f32x4){c.x, c.y, d.x, d.y}; }
                    v0 = v0 * sc; v1 = v1 * sc; u32x4 w; w.x = cvt_pk_bf16(v0[0], v0[1]); w.y = cvt_pk_bf16(v0[2], v0[3]); w.z = cvt_pk_bf16(v1[0], v1[1]); w.w = cvt_pk_bf16(v1[2], v1[3]);
                    *(u32x4*)(rowp + bj * HALF) = w; } }
    }
};

struct PanelStats {
    unsigned* xbuf;
    unsigned* cnt;
    unsigned* tmo;
    int ntn; float eps;
    unsigned code;
    __device__ __forceinline__ bool run(const f32x4 (&v)[2][2][4][2], const Unit& u, int wr, int wc, int fr, int fq, PG8_LAS unsigned char* lds, int wid, int lane) const {
        typedef float f32x2v __attribute__((ext_vector_type(2)));
        PG8_LAS f32x2v* P = (PG8_LAS f32x2v*)lds;
        PG8_LAS f32x2v* S = (PG8_LAS f32x2v*)(lds + 8192);
        PG8_LAS unsigned* flag = (PG8_LAS unsigned*)(lds + 8192 + 2048);
#pragma unroll
        for (int ai = 0; ai < 2; ++ai)
#pragma unroll
            for (int m = 0; m < 4; ++m) {
                float s = 0.f;
#pragma unroll
                for (int bj = 0; bj < 2; ++bj)
#pragma unroll
                    for (int n = 0; n < 2; ++n) { const f32x4 x = v[ai][bj][m][n]; s += (x[0] + x[1]) + (x[2] + x[3]); }
                s += __shfl_xor(s, 16); s += __shfl_xor(s, 32);
                const float mw = s * (1.0f / 64.0f); float q = 0.f;
#pragma unroll
                for (int bj = 0; bj < 2; ++bj)
#pragma unroll
                    for (int n = 0; n < 2; ++n) { const f32x4 d = v[ai][bj][m][n] - mw; q += (d[0] * d[0] + d[1] * d[1]) + (d[2] * d[2] + d[3] * d[3]); }
                q += __shfl_xor(q, 16); q += __shfl_xor(q, 32);
                if (fq == 0) P[(ai * HALF + wr * 64 + m * 16 + fr) * 4 + wc] = (f32x2v){mw, q};
            }
        asm volatile("s_waitcnt lgkmcnt(0)" ::: "memory"); __builtin_amdgcn_s_barrier(); asm volatile("" ::: "memory");
#if defined(BROKEN_EXCHANGE_NO_WAIT)
#warning BROKEN CONTROL BUILD: the row-statistics exchange does not wait; results are wrong by design
        if (blockIdx.x >= 64) { const long long t0_ = clock64(); while (clock64() - t0_ < 60000) __builtin_amdgcn_s_sleep(8); }
#endif
        const int row = wid * 32 + (lane & 31);
        if (lane < 32) {
            const f32x2v a = P[row * 4 + 0], b = P[row * 4 + 1], c = P[row * 4 + 2], d = P[row * 4 + 3];
            const float mt = (a.x + b.x + c.x + d.x) * 0.25f;
            const float da = a.x - mt, db = b.x - mt, dc = c.x - mt, dd = d.x - mt;
            const float m2 = (a.y + b.y) + (c.y + d.y) + 64.0f * ((da * da + db * db) + (dc * dc + dd * dd));
            unsigned long long* slot = (unsigned long long*)xbuf + ((size_t)(u.pm * BM + row) * 4 + u.pn);
            __hip_atomic_store(slot, ((unsigned long long)__float_as_uint(m2) << 32) | __float_as_uint(mt), __ATOMIC_RELAXED, __HIP_MEMORY_SCOPE_AGENT);
        }
        asm volatile("s_waitcnt vmcnt(0)" ::: "memory");
        if (lane == 0) __hip_atomic_fetch_add(cnt + 64 * u.pm, 1u, __ATOMIC_RELAXED, __HIP_MEMORY_SCOPE_AGENT);
        if (wid == 0) {
            bool dead = false; const unsigned long long t0 = __builtin_amdgcn_s_memrealtime(); const unsigned want = 8u * (unsigned)ntn;
            for (;;) {
#if defined(BROKEN_EXCHANGE_NO_WAIT)
                break;
#endif
                if ((unsigned)__builtin_amdgcn_readfirstlane(__hip_atomic_load(cnt + 64 * u.pm, __ATOMIC_RELAXED, __HIP_MEMORY_SCOPE_AGENT)) >= want) break;
                if (__builtin_amdgcn_s_memrealtime() - t0 > 2000000ull) {
                    if (lane == 0) { unsigned expect = 0u; __hip_atomic_compare_exchange_strong(tmo + 1, &expect, code | (unsigned)(u.pm & 0xff), __ATOMIC_RELAXED, __ATOMIC_RELAXED, __HIP_MEMORY_SCOPE_AGENT);
                                     __hip_atomic_store(tmo, 1u, __ATOMIC_RELAXED, __HIP_MEMORY_SCOPE_AGENT); }
                    dead = true; break; }
                __builtin_amdgcn_s_sleep(2);
            }
            __builtin_amdgcn_fence(__ATOMIC_ACQUIRE, "agent");
            if (lane == 0) flag[0] = dead ? 1u : 0u;
        }
        asm volatile("s_waitcnt vmcnt(0) lgkmcnt(0)" ::: "memory"); __builtin_amdgcn_s_barrier(); asm volatile("" ::: "memory");
        const bool bad = flag[0] != 0u;
        if (lane < 32) {
            const unsigned long long* slot = (const unsigned long long*)xbuf + (size_t)(u.pm * BM + row) * 4; float mt[4], m2[4]; float ms = 0.f;
#pragma unroll
            for (int t = 0; t < 4; ++t) { if (t < ntn) { const unsigned long long w = __hip_atomic_load(slot + t, __ATOMIC_RELAXED, __HIP_MEMORY_SCOPE_AGENT); mt[t] = __uint_as_float((unsigned)w); m2[t] = __uint_as_float((unsigned)(w >> 32)); } else { mt[t] = 0.f; m2[t] = 0.f; } ms += mt[t]; }
            const float mean = ms / (float)ntn; float q = 0.f;
#pragma unroll
            for (int t = 0; t < 4; ++t) if (t < ntn) { const float dm = mt[t] - mean; q += m2[t] + 256.0f * dm * dm; }
            S[row] = (f32x2v){mean, 1.0f / sqrtf(q / (256.0f * (float)ntn) + eps)};
        }
        asm volatile("s_waitcnt lgkmcnt(0)" ::: "memory"); __builtin_amdgcn_s_barrier(); asm volatile("" ::: "memory");
        return bad;
    }
};
struct EpiLnRes {
    static constexpr bool PERM = false, AFTER_DRAIN = true;
    const float* base; float* out; int ldc; const float* bias; PanelStats st; unsigned poison;
    __device__ __forceinline__ void fused(f32x4 (&acc)[2][2][4][2], const Unit& u, int wr, int wc, int fr, int fq, PG8_LAS unsigned char* lds, int wid, int lane) const {
        typedef float f32x2v __attribute__((ext_vector_type(2)));
        const PG8_LAS f32x2v* S = (const PG8_LAS f32x2v*)(lds + 8192);
        const int col0 = u.pn * BM + wc * 32 + 4 * fq;
#pragma unroll
        for (int bj = 0; bj < 2; ++bj)
#pragma unroll
            for (int n = 0; n < 2; ++n) { const f32x4 bv = bias ? *(const f32x4*)(bias + col0 + bj * HALF + n * 16) : (f32x4){0.f, 0.f, 0.f, 0.f};
#pragma unroll
                for (int ai = 0; ai < 2; ++ai)
#pragma unroll
                    for (int m = 0; m < 4; ++m) acc[ai][bj][m][n] += bv; }
        f32x4 pre[4][2][2];
#pragma unroll
        for (int m = 0; m < 4; ++m) { const size_t off = (size_t)(u.pm * BM + wr * 64 + m * 16 + fr) * ldc + col0;
#pragma unroll
            for (int bj = 0; bj < 2; ++bj)
#pragma unroll
                for (int n = 0; n < 2; ++n) pre[m][bj][n] = *(const f32x4*)(base + off + bj * HALF + n * 16); }
        const bool bad = st.run(acc, u, wr, wc, fr, fq, lds, wid, lane) || poison != 0u;
        const float qnan = __builtin_nanf("");
#pragma unroll
        for (int ai = 0; ai < 2; ++ai)
#pragma unroll
            for (int m = 0; m < 4; ++m) { const int r = ai * HALF + wr * 64 + m * 16 + fr; const f32x2v sr = S[r]; const size_t off = (size_t)(u.pm * BM + r) * ldc + col0;
#pragma unroll
                for (int bj = 0; bj < 2; ++bj)
#pragma unroll
                    for (int n = 0; n < 2; ++n) { const f32x4 bs = ai == 0 ? pre[m][bj][n] : *(const f32x4*)(base + off + bj * HALF + n * 16); f32x4 o = bs + (acc[ai][bj][m][n] - sr.x) * sr.y;
                        if (bad) o = (f32x4){qnan, qnan, qnan, qnan}; *(f32x4*)(out + off + bj * HALF + n * 16) = o; }
                if (m & 1) asm volatile("" ::: "memory"); }
    }
};
struct EpiLnResLn {
    static constexpr bool PERM = false, AFTER_DRAIN = true;
    const float* base; float* out; bf16_t* xn; int ldc; const float* bias; PanelStats st1, st2; unsigned poison;
    __device__ __forceinline__ void fused(f32x4 (&acc)[2][2][4][2], const Unit& u, int wr, int wc, int fr, int fq, PG8_LAS unsigned char* lds, int wid, int lane) const {
        typedef float f32x2v __attribute__((ext_vector_type(2))); typedef unsigned u32x2v __attribute__((ext_vector_type(2)));
        const PG8_LAS f32x2v* S = (const PG8_LAS f32x2v*)(lds + 8192);
        const int col0 = u.pn * BM + wc * 32 + 4 * fq;
#pragma unroll
        for (int bj = 0; bj < 2; ++bj)
#pragma unroll
            for (int n = 0; n < 2; ++n) { const f32x4 bv = bias ? *(const f32x4*)(bias + col0 + bj * HALF + n * 16) : (f32x4){0.f, 0.f, 0.f, 0.f};
#pragma unroll
                for (int ai = 0; ai < 2; ++ai)
#pragma unroll
                    for (int m = 0; m < 4; ++m) acc[ai][bj][m][n] += bv; }
        bool bad = st1.run(acc, u, wr, wc, fr, fq, lds, wid, lane) || poison != 0u;
        const float qnan = __builtin_nanf("");
#pragma unroll
        for (int ai = 0; ai < 2; ++ai)
#pragma unroll
            for (int m = 0; m < 4; ++m) { const int r = ai * HALF + wr * 64 + m * 16 + fr; const f32x2v sr = S[r]; const size_t off = (size_t)(u.pm * BM + r) * ldc + col0;
#pragma unroll
                for (int bj = 0; bj < 2; ++bj)
#pragma unroll
                    for (int n = 0; n < 2; ++n) { const f32x4 bs = *(const f32x4*)(base + off + bj * HALF + n * 16); acc[ai][bj][m][n] = bs + (acc[ai][bj][m][n] - sr.x) * sr.y; }
                asm volatile("" : "+v"(acc[ai][0][m][0]), "+v"(acc[ai][0][m][1]), "+v"(acc[ai][1][m][0]), "+v"(acc[ai][1][m][1]));
                if (m & 1) asm volatile("" ::: "memory"); }
        const bool bad1 = bad;
        bad = st2.run(acc, u, wr, wc, fr, fq, lds, wid, lane) || bad;
#pragma unroll
        for (int ai = 0; ai < 2; ++ai)
#pragma unroll
            for (int m = 0; m < 4; ++m) { const int r = ai * HALF + wr * 64 + m * 16 + fr; const f32x2v sr = S[r]; const size_t off = (size_t)(u.pm * BM + r) * ldc + col0;
#pragma unroll
                for (int bj = 0; bj < 2; ++bj)
#pragma unroll
                    for (int n = 0; n < 2; ++n) { const f32x4 x1 = acc[ai][bj][m][n]; *(f32x4*)(out + off + bj * HALF + n * 16) = bad1 ? (f32x4){qnan, qnan, qnan, qnan} : x1;
                        const f32x4 o = (x1 - sr.x) * sr.y; u32x2v w; w.x = cvt_pk_bf16(o[0], o[1]); w.y = cvt_pk_bf16(o[2], o[3]);
                        if (bad) { w.x = 0x7fc07fc0u; w.y = 0x7fc07fc0u; } *(u32x2v*)(xn + off + bj * HALF + n * 16) = w; }
                asm volatile("" ::: "memory"); }
    }
};

template <class Epi, class Sched, bool ALIGN_EPI = false, bool SP2 = false>
__device__ __forceinline__ void gemm_phase(PG8_LAS unsigned char* lds, const Gemm g, const Sched& S, const Epi& E, const int wid_in  ) {
    int wid_ = wid_in; asm volatile("" : "+s"(wid_)); const int wid = wid_;
    int lane_; asm volatile("v_mbcnt_lo_u32_b32 %0, -1, 0\n\tv_mbcnt_hi_u32_b32 %0, -1, %0" : "=v"(lane_));
    const int lane = lane_, tid = wid * 64 + lane, wr = wid >> 2, wc = wid & 3, fr = lane & 15, fq = lane >> 4;
    const int K = g.K, nt = K / BK;
    unsigned voffA[2], voffB[2];
#pragma unroll
    for (int i = 0; i < 2; ++i) { int R, C; stage_rc(tid * 16 + i * 8192, R, C); const int Rb = Epi::PERM ? ((R & ~31) + perm32(R & 31)) : R;
        voffA[i] = (unsigned)(R * K + C) * 2u; voffB[i] = (unsigned)(Rb * K + C) * 2u; }
    const size_t kstep = (size_t)(BK * 2);
    const size_t hstep = (size_t)HALF * K * 2;
    const size_t tstep = 2 * hstep;
    const unsigned ldsw = (unsigned)wid * 1024u;
    const int aoff = lds_byte(wr * 64 + fr, fq * 8), boff = lds_byte(wc * 32 + fr, fq * 8);
#define PG8_SA(b, h) (((b) * 2 + (h)) * HTB)
#define PG8_SB(b, h) ((4 + (b) * 2 + (h)) * HTB)
#define PG8_STAGE(bufoff, gbase, voff) do { _Pragma("unroll") for (int _i = 0; _i < 2; ++_i) \
        __builtin_amdgcn_global_load_lds((const unsigned*)((const char*)(gbase) + (voff)[_i]), (PG8_LAS unsigned*)(lds + (bufoff) + ldsw + _i * 8192), 16, 0, 0); } while (0)
#define PG8_LDA(dst, b, h) do { _Pragma("unroll") for (int m = 0; m < 4; ++m) _Pragma("unroll") for (int k = 0; k < 2; ++k) dst[m][k] = *(const PG8_LAS bf16x8*)(lds + PG8_SA(b, h) + aoff + m * 2048 + k * 1024); } while (0)
#define PG8_LDB(dst, b, h) do { _Pragma("unroll") for (int n = 0; n < 2; ++n) _Pragma("unroll") for (int k = 0; k < 2; ++k) dst[n][k] = *(const PG8_LAS bf16x8*)(lds + PG8_SB(b, h) + boff + n * 2048 + k * 1024); } while (0)
#define PG8_MMA(ai, bj, At, Bt) do { __builtin_amdgcn_s_setprio(1); _Pragma("unroll") for (int m = 0; m < 4; ++m) _Pragma("unroll") for (int n = 0; n < 2; ++n) _Pragma("unroll") for (int k = 0; k < 2; ++k) \
        acc[ai][bj][m][n] = __builtin_amdgcn_mfma_f32_16x16x32_bf16(Bt[n][k], At[m][k], acc[ai][bj][m][n], 0, 0, 0); __builtin_amdgcn_s_setprio(0); } while (0)
#define PG8_WAIT_V(n) asm volatile("s_waitcnt vmcnt(" #n ")" ::: "memory")
#define PG8_WAIT_L(n) asm volatile("s_waitcnt lgkmcnt(" #n ")" ::: "memory")
#define PG8_BAR __builtin_amdgcn_s_barrier()
#define PG8_SCHED __builtin_amdgcn_sched_barrier(0)
    Unit cur, nxt; int ui = 0;
    if (!S.next(0, cur)) return;
    f32x4 acc[2][2][4][2];
#pragma unroll
    for (int a = 0; a < 2; ++a)
#pragma unroll
        for (int b = 0; b < 2; ++b)
#pragma unroll
            for (int m = 0; m < 4; ++m)
#pragma unroll
                for (int n = 0; n < 2; ++n) acc[a][b][m][n] = (f32x4){0.f, 0.f, 0.f, 0.f};
    bf16x8 At[4][2], B0[2][2], B1[2][2];
    const char* cA = (const char*)g.A + (size_t)cur.pm * tstep; const char* cB = (const char*)g.Bt + (size_t)cur.pn * tstep;
    S.a_ready(cur);
    if constexpr (SP2) {
        PG8_STAGE(PG8_SB(0, 0), cB, voffB); PG8_STAGE(PG8_SB(0, 1), cB + hstep, voffB); PG8_STAGE(PG8_SA(0, 0), cA, voffA); PG8_STAGE(PG8_SA(0, 1), cA + hstep, voffA);
        if (wr == 1) PG8_BAR;
        PG8_WAIT_V(2); PG8_BAR;
        PG8_STAGE(PG8_SB(1, 0), cB + kstep, voffB); PG8_STAGE(PG8_SA(1, 0), cA + kstep, voffA); PG8_STAGE(PG8_SB(1, 1), cB + hstep + kstep, voffB);
        PG8_WAIT_V(6); PG8_BAR;
    } else {
        PG8_STAGE(PG8_SB(0, 0), cB, voffB); PG8_STAGE(PG8_SA(0, 0), cA, voffA); PG8_STAGE(PG8_SB(0, 1), cB + hstep, voffB); PG8_STAGE(PG8_SA(0, 1), cA + hstep, voffA);
        if (wr == 1) PG8_BAR;
        PG8_WAIT_V(4); PG8_BAR;
        PG8_STAGE(PG8_SB(1, 0), cB + kstep, voffB); PG8_STAGE(PG8_SA(1, 0), cA + kstep, voffA); PG8_STAGE(PG8_SB(1, 1), cB + hstep + kstep, voffB);
        PG8_WAIT_V(6); PG8_BAR;
    }
    for (;;) {
        const bool has_next = S.next(ui + 1, nxt);
        const char* nA = has_next ? (const char*)g.A + (size_t)nxt.pm * tstep : cA; const char* nB = has_next ? (const char*)g.Bt + (size_t)nxt.pn * tstep : cB;
        for (int t = 0; t < nt; t += 2) {
            const bool last = (t == nt - 2);
            const char* a1 = cA + (size_t)(t + 1) * kstep;
            const char* a2 = last ? nA : cA + (size_t)(t + 2) * kstep; const char* b2 = last ? nB : cB + (size_t)(t + 2) * kstep;
            const char* a3 = a2 + kstep; const char* b3 = b2 + kstep;
            if (last && has_next) S.a_ready(nxt);
            if constexpr (SP2) {
            PG8_LDB(B0, 0, 0); PG8_LDB(B1, 0, 1); PG8_SCHED; PG8_LDA(At, 0, 0); PG8_STAGE(PG8_SA(1, 1), a1 + hstep, voffA);
            PG8_WAIT_V(8); PG8_WAIT_L(0); PG8_BAR; PG8_MMA(0, 0, At, B0); PG8_MMA(0, 1, At, B1); PG8_BAR; PG8_SCHED;
            PG8_LDA(At, 0, 1); PG8_STAGE(PG8_SB(0, 0), b2, voffB); PG8_STAGE(PG8_SB(0, 1), b2 + hstep, voffB); PG8_STAGE(PG8_SA(0, 0), a2, voffA);
            PG8_WAIT_V(8); PG8_WAIT_L(0); PG8_BAR; PG8_MMA(1, 0, At, B0); PG8_MMA(1, 1, At, B1); PG8_BAR; PG8_SCHED;
            PG8_LDB(B0, 1, 0); PG8_LDB(B1, 1, 1); PG8_SCHED; PG8_LDA(At, 1, 0); PG8_STAGE(PG8_SA(0, 1), a2 + hstep, voffA);
            PG8_WAIT_V(8); PG8_WAIT_L(0); PG8_BAR; PG8_MMA(0, 0, At, B0); PG8_MMA(0, 1, At, B1); PG8_BAR; PG8_SCHED;
            PG8_LDA(At, 1, 1); PG8_STAGE(PG8_SB(1, 0), b3, voffB); PG8_STAGE(PG8_SB(1, 1), b3 + hstep, voffB); PG8_STAGE(PG8_SA(1, 0), a3, voffA);
            PG8_WAIT_V(8); PG8_WAIT_L(0); PG8_BAR; PG8_MMA(1, 0, At, B0); PG8_MMA(1, 1, At, B1); PG8_BAR; PG8_SCHED;
            } else {
            PG8_LDB(B0, 0, 0); PG8_SCHED; PG8_LDA(At, 0, 0); PG8_STAGE(PG8_SA(1, 1), a1 + hstep, voffA);
            PG8_WAIT_L(8); PG8_BAR; PG8_WAIT_L(0); PG8_MMA(0, 0, At, B0); PG8_BAR; PG8_SCHED;
            PG8_LDB(B1, 0, 1); PG8_STAGE(PG8_SB(0, 0), b2, voffB);
            PG8_BAR; PG8_WAIT_L(0); PG8_MMA(0, 1, At, B1); PG8_BAR;
            PG8_LDA(At, 0, 1); PG8_STAGE(PG8_SA(0, 0), a2, voffA);
            PG8_BAR; PG8_WAIT_L(0); PG8_MMA(1, 0, At, B0); PG8_BAR; PG8_SCHED;
            PG8_STAGE(PG8_SB(0, 1), b2 + hstep, voffB);
            PG8_WAIT_V(6); PG8_BAR; PG8_MMA(1, 1, At, B1); PG8_BAR;
            PG8_LDB(B0, 1, 0); PG8_SCHED; PG8_LDA(At, 1, 0); PG8_STAGE(PG8_SA(0, 1), a2 + hstep, voffA);
            PG8_WAIT_L(8); PG8_BAR; PG8_WAIT_L(0); PG8_MMA(0, 0, At, B0); PG8_BAR; PG8_SCHED;
            PG8_LDB(B1, 1, 1); PG8_STAGE(PG8_SB(1, 0), b3, voffB);
            PG8_BAR; PG8_WAIT_L(0); PG8_MMA(0, 1, At, B1); PG8_BAR;
            PG8_LDA(At, 1, 1); PG8_STAGE(PG8_SA(1, 0), a3, voffA);
            PG8_BAR; PG8_WAIT_L(0); PG8_MMA(1, 0, At, B0); PG8_BAR; PG8_SCHED;
            PG8_STAGE(PG8_SB(1, 1), b3 + hstep, voffB);
            PG8_WAIT_V(6); PG8_BAR; PG8_MMA(1, 1, At, B1); PG8_BAR;
            }
        }
        if constexpr (ALIGN_EPI) { if (wr == 0) PG8_BAR; }
        if constexpr (!Epi::AFTER_DRAIN) { E(acc, cur, wr, wc, fr, fq); S.done(cur); }
        if (!has_next) break;
#pragma unroll
        for (int a = 0; a < 2; ++a)
#pragma unroll
            for (int b = 0; b < 2; ++b)
#pragma unroll
                for (int m = 0; m < 4; ++m)
#pragma unroll
                    for (int n = 0; n < 2; ++n) acc[a][b][m][n] = (f32x4){0.f, 0.f, 0.f, 0.f};
        cur = nxt; cA = nA; cB = nB; ++ui;
        if constexpr (ALIGN_EPI) { if (wr == 1) PG8_BAR; }
    }
    PG8_WAIT_V(0);
    if constexpr (!ALIGN_EPI) { if (wr == 0) PG8_BAR; }
    PG8_BAR;
    if constexpr (Epi::AFTER_DRAIN) { E.fused(acc, cur, wr, wc, fr, fq, lds, wid, lane); S.done(cur); }
#undef PG8_SA
#undef PG8_SB
#undef PG8_STAGE
#undef PG8_LDA
#undef PG8_LDB
#undef PG8_MMA
#undef PG8_WAIT_V
#undef PG8_WAIT_L
#undef PG8_BAR
#undef PG8_SCHED
}
}
constexpr int NWAVES = 8;
constexpr int DM = 1024, NB = 8, SEQ = 2048, DEPTH = 4, SBATCH = 8, SSEQ = 16, PAST = 4096;
constexpr int MP = NB * SEQ, MS = SBATCH * SSEQ, MALL = MP + MS, MPAD = 16640;
constexpr int WA = 512, DFF = 2816, PLE = 256, INC = 5128, NPROJ = 5120, NGU = 2 * DFF;
constexpr float LN_EPS = 1e-5f, RMS_EPS = 1e-5f;
constexpr float LOG2E = 1.4426950408889634f;
constexpr float C2 = 0.125f * LOG2E;
constexpr float ALPHA = 1.6817928305074290f;
enum { I_XP = 0, I_XS, I_PP, I_PS, I_CFK, I_CFV, I_CFL, I_CDK, I_CDV, I_WIN, I_BF, I_LQ1, I_LK1, I_LQ2, I_LK2, I_GD, I_WBA, I_WBB, I_WO, I_L1G, I_L1B, I_WG, I_WU, I_WD, I_WPG, I_WPP, I_L2G, I_L2B, N_IN };
constexpr size_t O_YP = 0, O_YS = O_YP + (size_t)MP * DM, O_FKP = O_YS + (size_t)MS * DM, O_FVP = O_FKP + (size_t)DEPTH * MP * 512, O_FLP = O_FVP + (size_t)DEPTH * MP * 512,
                 O_DKP = O_FLP + (size_t)DEPTH * MP * 8, O_DVP = O_DKP + (size_t)DEPTH * MP * 512, O_FKS = O_DVP + (size_t)DEPTH * MP * 512, O_FVS = O_FKS + (size_t)DEPTH * MS * 512,
                 O_FLS = O_FVS + (size_t)DEPTH * MS * 512, O_DKS = O_FLS + (size_t)DEPTH * MS * 8, O_DVS = O_DKS + (size_t)DEPTH * MS * 512, O_END = O_DVS + (size_t)DEPTH * MS * 512;
static_assert(O_END == 152702976ull, "output size");

constexpr size_t MiB = 1u << 20;
constexpr size_t WS_CTL = 0, CTL_ZERO_BYTES = 1 * MiB;
constexpr size_t WL_IN = 0, WL_BA = WL_IN + (size_t)NPROJ * DM * 2, WL_BB = WL_BA + (size_t)DM * 512 * 2, WL_O = WL_BB + (size_t)DM * 512 * 2, WL_GU = WL_O + (size_t)DM * DM * 2,
                 WL_D = WL_GU + (size_t)NGU * DM * 2, WL_PG = WL_D + (size_t)DM * DFF * 2, WL_PPW = WL_PG + (size_t)DM * DM * 2, WL_SIZE = WL_PPW + (size_t)DM * PLE * 2;
constexpr size_t WS_W = 2 * MiB;
constexpr size_t align_up(size_t x) { return (x + 4095) & ~(size_t)4095; }
constexpr size_t WS_XF = align_up(WS_W + DEPTH * WL_SIZE);
constexpr size_t WS_XB = WS_XF + (size_t)MPAD * DM * 4;
constexpr size_t WS_QA = WS_XB + (size_t)MPAD * DM * 2;
constexpr size_t SZ_H = (size_t)MPAD * 512 * 2;
constexpr size_t WS_KA = WS_QA + SZ_H, WS_VA = WS_KA + SZ_H, WS_QB = WS_VA + SZ_H, WS_KB = WS_QB + SZ_H, WS_VB = WS_KB + SZ_H;
constexpr size_t WS_G = WS_VB + SZ_H;
constexpr size_t WS_OA = WS_G + (size_t)MPAD * 2048 * 2;
constexpr size_t WS_OB = WS_OA + SZ_H;
constexpr size_t WS_O12 = WS_OB + SZ_H;
constexpr size_t WS_T1 = WS_O12 + (size_t)MPAD * DM * 4;
constexpr size_t WS_MG = WS_T1 + (size_t)MPAD * DM * 4;
constexpr size_t WS_PRE = WS_MG + (size_t)MPAD * DM * 2;
constexpr size_t WS_HB = WS_PRE + (size_t)MPAD * DM * 4;
constexpr size_t WS_PPO = WS_HB + (size_t)MPAD * DFF * 2;
constexpr size_t WS_PLE = WS_PPO + (size_t)MPAD * DM * 4;
constexpr size_t WS_PB = WS_PLE + (size_t)MPAD * DM * 4;
constexpr size_t WS_LF = WS_PB + (size_t)DEPTH * MPAD * PLE * 2;
constexpr size_t WS_CKP = WS_LF + (size_t)MPAD * 8 * 4;
constexpr size_t WS_CKS = WS_CKP + (size_t)64 * SEQ * 4;
constexpr size_t WS_CP = WS_CKS + 4096;
constexpr size_t WS_END = WS_CP + (size_t)DEPTH * 64 * PAST * 4;
constexpr int CW_TMO = 0, CW_CODE = 1, CW_BAR = 4096;
#define GAS __attribute__((address_space(1)))
#define LAS __attribute__((address_space(3)))
typedef unsigned short bf16;
typedef unsigned v4u __attribute__((ext_vector_type(4)));
typedef float f32x4 __attribute__((ext_vector_type(4)));
typedef short bf16x8 __attribute__((ext_vector_type(8)));
typedef GAS unsigned gu32;
typedef GAS unsigned long long gu64;
#define RLX_AGENT __ATOMIC_RELAXED, __HIP_MEMORY_SCOPE_AGENT
#define LDS_WAIT() asm volatile("s_waitcnt lgkmcnt(0)" ::: "memory")
#define VM_WAIT() asm volatile("s_waitcnt vmcnt(0)" ::: "memory")
__device__ __forceinline__ unsigned long long rt() { return __builtin_amdgcn_s_memrealtime(); }
__device__ __forceinline__ unsigned f2bf(float f) { unsigned u = __builtin_bit_cast(unsigned, f); return (u + 0x7fffu + ((u >> 16) & 1u)) >> 16; }
__device__ __forceinline__ unsigned pk2(float lo, float hi) { return f2bf(lo) | (f2bf(hi) << 16); }

#define XB_TMO      128
#define XB_XCNT(j)  (256  + 64 * (j))
#define XB_XSUB(j)  (1280 + 64 * (j))
#define XB_XGEN(j)  (2304 + 64 * (j))
#define XB_TOP      3328
#define XB_TOPGEN   3392
#define XCD_BAR_WORDS 3456
#define XB_SPIN_CAP (1u << 18)

__device__ __forceinline__ unsigned xb_ld(unsigned* p)              { return __hip_atomic_load(p, __ATOMIC_RELAXED, __HIP_MEMORY_SCOPE_AGENT); }
__device__ __forceinline__ unsigned xb_add(unsigned* p, unsigned v) { return __hip_atomic_fetch_add(p, v, __ATOMIC_RELAXED, __HIP_MEMORY_SCOPE_AGENT); }
__device__ __forceinline__ unsigned xb_xcc_id() { return (unsigned)__builtin_amdgcn_s_getreg((3 << 11) | 20) & 0xFu; }
#define XB_SPIN(cond, bar) do { unsigned _sp = 0; while (cond) { __builtin_amdgcn_s_sleep(1); \
    if ((++_sp & 255u) == 0u) { if (xb_ld(&(bar)[XB_TMO])) break; if (_sp > XB_SPIN_CAP) { atomicAdd(&(bar)[XB_TMO], 1u); break; } } } } while (0)

struct XcdBarrier {
    unsigned* bar; unsigned x;
    volatile LAS unsigned* st;
};

__device__ __forceinline__ XcdBarrier xcd_barrier_post(unsigned* bar, volatile LAS unsigned* st) {
    XcdBarrier b; b.bar = bar; b.x = xb_xcc_id(); b.st = st;
    if (threadIdx.x == 0) (void)xb_add(&bar[XB_XCNT(b.x)], 1u);
    return b;
}
__device__ __forceinline__ void xcd_barrier_complete(unsigned* bar, unsigned x, unsigned& nloc, unsigned& nx) {
    const unsigned G = gridDim.x * gridDim.y * gridDim.z;
    unsigned sum, cnt, mine, sp = 0u;
    for (;;) {
        sum = 0u; cnt = 0u; mine = 0u;
#pragma unroll
        for (unsigned j = 0; j < 16; ++j) { const unsigned c = xb_ld(&bar[XB_XCNT(j)]); sum += c; cnt += (c > 0u) ? 1u : 0u; mine = (j == x) ? c : mine; }
        if (sum == G) break;
        __builtin_amdgcn_s_sleep(1);
        if ((++sp & 255u) == 0u) { if (xb_ld(&bar[XB_TMO])) break; if (sp > XB_SPIN_CAP) { atomicAdd(&bar[XB_TMO], 1u); break; } }
    }
    nloc = mine > 0u ? mine : 1u; nx = cnt > 0u ? cnt : 1u;
}

__device__ __forceinline__ void xcd_barrier(const XcdBarrier& b) {
    asm volatile("s_waitcnt vmcnt(0)" ::: "memory");
    __syncthreads();
    if (threadIdx.x == 0) {
        unsigned* bar = b.bar;
        __builtin_amdgcn_s_waitcnt(0);
        unsigned nloc = b.st[0], nx = b.st[1];
        if (nloc == 0u) { xcd_barrier_complete(bar, b.x, nloc, nx); b.st[0] = nloc; b.st[1] = nx; }
        const unsigned old = xb_add(&bar[XB_XSUB(b.x)], 1u);
        const unsigned gen = old / nloc;
        if (old + 1u == (gen + 1u) * nloc) {
            __builtin_amdgcn_fence(__ATOMIC_RELEASE, "agent");
            asm volatile("s_waitcnt vmcnt(0)" ::: "memory");
            const unsigned og = xb_add(&bar[XB_TOP], 1u);
            const unsigned tg = og / nx;
            if (og + 1u == (tg + 1u) * nx) xb_add(&bar[XB_TOPGEN], 1u);
            else XB_SPIN(xb_ld(&bar[XB_TOPGEN]) == tg, bar);
            __builtin_amdgcn_fence(__ATOMIC_ACQUIRE, "agent");
            xb_add(&bar[XB_XGEN(b.x)], 1u);
            asm volatile("s_waitcnt vmcnt(0)" ::: "memory");
        } else {
            XB_SPIN(xb_ld(&bar[XB_XGEN(b.x)]) == gen, bar);
            __builtin_amdgcn_fence(__ATOMIC_ACQUIRE, "agent");
            asm volatile("s_waitcnt vmcnt(0)" ::: "memory");
        }
    }
    __syncthreads();
}
namespace epi {
using pg8::f32x4; using pg8::Unit; using pg8::BM; using pg8::HALF; using pg8::bf16_t; using pg8::u32x4; using pg8::cvt_pk_bf16;
__device__ __forceinline__ float bf2f(unsigned short b) { return __uint_as_float((unsigned)b << 16); }
__device__ __forceinline__ float sigm(float v) { return 1.0f / (1.0f + __expf(-v)); }
__device__ __forceinline__ u32x4 pack8(const f32x4& a, const f32x4& b) { u32x4 w; w.x = cvt_pk_bf16(a[0], a[1]); w.y = cvt_pk_bf16(a[2], a[3]); w.z = cvt_pk_bf16(b[0], b[1]); w.w = cvt_pk_bf16(b[2], b[3]); return w; }
__device__ __forceinline__ void unpack8(const u32x4& w, f32x4& a, f32x4& b) {
    a[0] = __uint_as_float(w.x << 16); a[1] = __uint_as_float(w.x & 0xffff0000u); a[2] = __uint_as_float(w.y << 16); a[3] = __uint_as_float(w.y & 0xffff0000u);
    b[0] = __uint_as_float(w.z << 16); b[1] = __uint_as_float(w.z & 0xffff0000u); b[2] = __uint_as_float(w.w << 16); b[3] = __uint_as_float(w.w & 0xffff0000u); }
template <class F> struct EpiRow8 {
    static constexpr bool PERM = true, AFTER_DRAIN = false; F f;
    __device__ __forceinline__ void operator()(const f32x4 (&acc)[2][2][4][2], const Unit& u, int wr, int wc, int fr, int fq) const {
        const int row0 = u.pm * BM + wr * 64 + fr, col0 = u.pn * BM + wc * 32 + 8 * fq;
#pragma unroll
        for (int ai = 0; ai < 2; ++ai)
#pragma unroll
            for (int m = 0; m < 4; ++m)
#pragma unroll
                for (int bj = 0; bj < 2; ++bj) f(row0 + ai * HALF + m * 16, col0 + bj * HALF, acc[ai][bj][m][0], acc[ai][bj][m][1]);
    }
};
struct EpiSwiGLU {
    static constexpr bool PERM = true, AFTER_DRAIN = false; bf16_t* H; int ldh;
    __device__ __forceinline__ void operator()(const f32x4 (&acc)[2][2][4][2], const Unit& u, int wr, int wc, int fr, int fq) const {
        const int row0 = u.pm * BM + wr * 64 + fr, col0 = u.pn * HALF + wc * 32 + 8 * fq;
#pragma unroll
        for (int ai = 0; ai < 2; ++ai)
#pragma unroll
            for (int m = 0; m < 4; ++m) { f32x4 o0, o1;
#pragma unroll
                for (int e = 0; e < 4; ++e) { const float g0 = acc[ai][0][m][0][e], g1 = acc[ai][0][m][1][e]; o0[e] = g0 * sigm(g0) * acc[ai][1][m][0][e]; o1[e] = g1 * sigm(g1) * acc[ai][1][m][1][e]; }
                *(u32x4*)(H + (size_t)(row0 + ai * HALF + m * 16) * ldh + col0) = pack8(o0, o1); }
    }
};
struct FProj {
    unsigned char* ws; float* out; int l;
    __device__ __forceinline__ void operator()(int row, int col, f32x4 v0, f32x4 v1) const {
        const int pn = col >> 8;
        if (pn < 12) { const int kind = pn >> 1, cw = col - kind * 512;
            if (kind == 0 || kind == 3) { v0 = v0 * C2; v1 = v1 * C2; }
            else if (row < MALL) {
                const size_t oP = kind == 1 ? O_FKP : (kind == 2 ? O_FVP : (kind == 4 ? O_DKP : O_DVP)), oS = kind == 1 ? O_FKS : (kind == 2 ? O_FVS : (kind == 4 ? O_DKS : O_DVS));
                float* o = (row < MP) ? out + oP + ((size_t)l * MP + row) * 512 + cw : out + oS + ((size_t)l * MS + (row - MP)) * 512 + cw; *(f32x4*)o = v0; *(f32x4*)(o + 4) = v1; }
            *(u32x4*)((bf16_t*)(ws + WS_QA + (size_t)kind * SZ_H) + (size_t)row * 512 + cw) = pack8(v0, v1);
        } else { f32x4 s0, s1;
#pragma unroll
            for (int e = 0; e < 4; ++e) { s0[e] = sigm(v0[e]); s1[e] = sigm(v1[e]); }
            *(u32x4*)((bf16_t*)(ws + WS_G) + (size_t)row * 2048 + (col - 3072)) = pack8(s0, s1); }
    }
};
struct FGate1 { const bf16_t* G; float* T1;
    __device__ __forceinline__ void operator()(int row, int col, f32x4 v0, f32x4 v1) const { f32x4 g0, g1; unpack8(*(const u32x4*)(G + (size_t)row * 2048 + col), g0, g1);
        float* o = T1 + (size_t)row * DM + col; *(f32x4*)o = g0 * v0; *(f32x4*)(o + 4) = g1 * v1; } };
struct FGate2 { const bf16_t* G; const float* T1; bf16_t* MGo;
    __device__ __forceinline__ void operator()(int row, int col, f32x4 v0, f32x4 v1) const { f32x4 g0, g1; unpack8(*(const u32x4*)(G + (size_t)row * 2048 + 1024 + col), g0, g1);
        const float* t = T1 + (size_t)row * DM + col; const f32x4 a = *(const f32x4*)t + g0 * v0, b = *(const f32x4*)(t + 4) + g1 * v1;
        *(u32x4*)(MGo + (size_t)row * DM + col) = pack8(a, b); } };
struct FRes { const float* X; const float* Add; float* PRE;
    __device__ __forceinline__ void operator()(int row, int col, f32x4 v0, f32x4 v1) const { const size_t off = (size_t)row * DM + col;
        f32x4 a = *(const f32x4*)(X + off) * ALPHA + v0, b = *(const f32x4*)(X + off + 4) * ALPHA + v1;
        if (Add) { a = a + *(const f32x4*)(Add + off); b = b + *(const f32x4*)(Add + off + 4); }
        *(f32x4*)(PRE + off) = a; *(f32x4*)(PRE + off + 4) = b; } };
struct FStoreF32 { float* O;
    __device__ __forceinline__ void operator()(int row, int col, f32x4 v0, f32x4 v1) const { float* o = O + (size_t)row * DM + col; *(f32x4*)o = v0; *(f32x4*)(o + 4) = v1; } };
struct FPleGate { const float* PPo; float* PLEo;
    __device__ __forceinline__ void operator()(int row, int col, f32x4 v0, f32x4 v1) const { const size_t off = (size_t)row * DM + col; f32x4 a = *(const f32x4*)(PPo + off), b = *(const f32x4*)(PPo + off + 4);
#pragma unroll
        for (int e = 0; e < 4; ++e) { a[e] *= sigm(v0[e]); b[e] *= sigm(v1[e]); }
        *(f32x4*)(PLEo + off) = a; *(f32x4*)(PLEo + off + 4) = b; } };
}
constexpr int RING_OFF = 0, RING_BYTES = 131072;
constexpr int LDSCTL_OFF = RING_BYTES, MISC_OFF = LDSCTL_OFF + 320;
constexpr int LDS_BYTES = 147456;
struct Args { const float* in[N_IN]; float* out; unsigned char* ws; int ph_lo, ph_hi; };
#define GIN(A, i) ((const float*)(const GAS float*)(A)->in[i])
#define GOUT(A) ((float*)(GAS float*)(A)->out)
#define GWS(A) ((unsigned char*)(GAS unsigned char*)(A)->ws)
static_assert(sizeof(Args) == (N_IN + 2) * 8 + 8, "Args has no padding");
struct Frame {
    LAS unsigned char* lds; volatile LAS unsigned* MISC; gu32* ctl;
    int tid, lane, wave, vcu, G;
};
__device__ __forceinline__ float lane_get(float v, int src_lane) { return __int_as_float(__builtin_amdgcn_ds_bpermute(src_lane << 2, __float_as_int(v))); }
__device__ __forceinline__ float wave_sum(float v, int lane) {
#pragma unroll
    for (int o = 1; o < 64; o <<= 1) v += lane_get(v, lane ^ o);
    return v;
}
__device__ __forceinline__ void transpose_tile(const float* src, int ldw, bf16* dst, int ldt, LAS float* scr, int lane) {
#pragma unroll 8
    for (int i = 0; i < 32; ++i) { const int kk = 2 * i + (lane >> 5); scr[kk * 33 + (lane & 31)] = src[(size_t)kk * ldw + (lane & 31)]; }
    LDS_WAIT(); asm volatile("" ::: "memory");
    const int c = lane & 7;
#pragma unroll
    for (int j = 0; j < 4; ++j) { const int n = (lane >> 3) + 8 * j; const LAS float* s = scr + (8 * c) * 33 + n;
        v4u o; o.x = pk2(s[0 * 33], s[1 * 33]); o.y = pk2(s[2 * 33], s[3 * 33]); o.z = pk2(s[4 * 33], s[5 * 33]); o.w = pk2(s[6 * 33], s[7 * 33]);
        *(GAS v4u*)(dst + (size_t)n * ldt + 8 * c) = o; }
    LDS_WAIT(); asm volatile("" ::: "memory");
}
__device__ __forceinline__ float lambda_init_of(int l) { return 0.8f - 0.6f * __expf(-0.3f * (float)l); }

template <class AP> __device__ __forceinline__ void p0_prologue(Frame& F, const AP A) {
    unsigned char* ws = GWS(A);
    LAS float* scr = (LAS float*)(F.lds + RING_OFF + F.wave * 16384);
    const int gw = F.vcu * NWAVES + F.wave, NGW = F.G * NWAVES;
    constexpr int I_IN = 16 * (NPROJ / 32), I_BA = 8 * 32, I_O = 16 * 32, I_G = 16 * (DFF / 32), I_D = (DFF / 64) * 32, I_PPW = 4 * 32;
    constexpr int PER_L = I_IN + 2 * I_BA + I_O + 2 * I_G + I_D + I_O + I_PPW;
    for (int it = gw; it < DEPTH * PER_L; it += NGW) {
        const int l = it / PER_L; int r = it % PER_L; unsigned char* wl = ws + WS_W + (size_t)l * WL_SIZE;
        if (r < I_IN) { const int nblk = NPROJ / 32, kb = r / nblk, nb = r % nblk, n0 = 32 * nb, sc = n0 < 1536 ? n0 : n0 + 8;
            transpose_tile(GIN(A, I_WIN) + (size_t)l * DM * INC + (size_t)(64 * kb) * INC + sc, INC, (bf16*)(wl + WL_IN) + (size_t)n0 * DM + 64 * kb, DM, scr, F.lane); continue; } r -= I_IN;
        if (r < I_BA) { const int kb = r / 32, nb = r % 32; transpose_tile(GIN(A, I_WBA) + (size_t)l * 512 * DM + (size_t)(64 * kb) * DM + 32 * nb, DM, (bf16*)(wl + WL_BA) + (size_t)(32 * nb) * 512 + 64 * kb, 512, scr, F.lane); continue; } r -= I_BA;
        if (r < I_BA) { const int kb = r / 32, nb = r % 32; transpose_tile(GIN(A, I_WBB) + (size_t)l * 512 * DM + (size_t)(64 * kb) * DM + 32 * nb, DM, (bf16*)(wl + WL_BB) + (size_t)(32 * nb) * 512 + 64 * kb, 512, scr, F.lane); continue; } r -= I_BA;
        if (r < I_O) { const int kb = r / 32, nb = r % 32; transpose_tile(GIN(A, I_WO) + (size_t)l * DM * DM + (size_t)(64 * kb) * DM + 32 * nb, DM, (bf16*)(wl + WL_O) + (size_t)(32 * nb) * DM + 64 * kb, DM, scr, F.lane); continue; } r -= I_O;
        if (r < 2 * I_G) { const int which = r / I_G; r %= I_G; const int nblk = DFF / 32, kb = r / nblk, nb = r % nblk, n0 = 32 * nb, dr = (n0 / 128) * 256 + (n0 % 128) + which * 128;
            transpose_tile((which ? GIN(A, I_WU) : GIN(A, I_WG)) + (size_t)l * DM * DFF + (size_t)(64 * kb) * DFF + n0, DFF, (bf16*)(wl + WL_GU) + (size_t)dr * DM + 64 * kb, DM, scr, F.lane); continue; } r -= 2 * I_G;
        if (r < I_D) { const int kb = r / 32, nb = r % 32; transpose_tile(GIN(A, I_WD) + (size_t)l * DFF * DM + (size_t)(64 * kb) * DM + 32 * nb, DM, (bf16*)(wl + WL_D) + (size_t)(32 * nb) * DFF + 64 * kb, DFF, scr, F.lane); continue; } r -= I_D;
        if (r < I_O) { const int kb = r / 32, nb = r % 32; transpose_tile(GIN(A, I_WPG) + (size_t)l * DM * DM + (size_t)(64 * kb) * DM + 32 * nb, DM, (bf16*)(wl + WL_PG) + (size_t)(32 * nb) * DM + 64 * kb, DM, scr, F.lane); continue; } r -= I_O;
        { const int kb = r / 32, nb = r % 32; transpose_tile(GIN(A, I_WPP) + (size_t)l * PLE * DM + (size_t)(64 * kb) * DM + 32 * nb, DM, (bf16*)(wl + WL_PPW) + (size_t)(32 * nb) * PLE + 64 * kb, PLE, scr, F.lane); }
    }
    float* XF = (float*)(ws + WS_XF); bf16* XB = (bf16*)(ws + WS_XB);
    for (int m = gw; m < MPAD; m += NGW) {
        const float* src = m < MP ? GIN(A, I_XP) + (size_t)m * DM : (m < MALL ? GIN(A, I_XS) + (size_t)(m - MP) * DM : nullptr);
#pragma unroll
        for (int j = 0; j < 4; ++j) { f32x4 v = src ? *((const GAS f32x4*)src + F.lane + 64 * j) : (f32x4){0.f, 0.f, 0.f, 0.f};
            *((GAS f32x4*)(XF + (size_t)m * DM) + F.lane + 64 * j) = v;
            *((GAS unsigned long long*)(XB + (size_t)m * DM) + F.lane + 64 * j) = (unsigned long long)pk2(v.x, v.y) | ((unsigned long long)pk2(v.z, v.w) << 32); }
    }
    bf16* PB = (bf16*)(ws + WS_PB);
    for (int it = gw; it < DEPTH * MPAD; it += NGW) { const int l = it / MPAD, m = it % MPAD;
        const float* src = m < MP ? GIN(A, I_PP) + ((size_t)l * MP + m) * PLE : (m < MALL ? GIN(A, I_PS) + ((size_t)l * MS + (m - MP)) * PLE : nullptr);
        f32x4 v = src ? *((const GAS f32x4*)src + F.lane) : (f32x4){0.f, 0.f, 0.f, 0.f};
        *((GAS unsigned long long*)(PB + (size_t)it * PLE) + F.lane) = (unsigned long long)pk2(v.x, v.y) | ((unsigned long long)pk2(v.z, v.w) << 32); }
    float* CP = (float*)(ws + WS_CP);
    for (int s = gw; s < DEPTH * 64; s += NGW) { const int lb = s >> 3, h = s & 7; const float* src = GIN(A, I_CFL) + (size_t)lb * PAST * 8 + h;
        float v[64]; float run = 0.f;
#pragma unroll
        for (int j = 0; j < 64; ++j) { run += src[(size_t)(F.lane * 64 + j) * 8]; v[j] = run; }
        float tot = run, incl = tot;
#pragma unroll
        for (int o = 1; o < 64; o <<= 1) { const float t = lane_get(incl, (F.lane - o) & 63); if (F.lane >= o) incl += t; }
        const float excl = incl - tot;
#pragma unroll
        for (int j = 0; j < 64; ++j) CP[(size_t)s * PAST + F.lane * 64 + j] = v[j] + excl;
    }
}
template <class AP> __device__ __forceinline__ void logf_phase(Frame& F, const AP A, int l) {
    unsigned char* ws = GWS(A); const float* XF = (const float*)(ws + WS_XF); float* LF = (float*)(ws + WS_LF);
    LAS float* wf = (LAS float*)(F.lds + RING_OFF);
    const float* win = GIN(A, I_WIN) + (size_t)l * DM * INC + 1536;
    for (int e = F.tid; e < 8 * DM; e += NWAVES * 64) { const int k = e >> 3, h = e & 7; wf[h * DM + k] = win[(size_t)k * INC + h]; }
    __syncthreads();
    const int gw = F.vcu * NWAVES + F.wave, NGW = F.G * NWAVES;
    const float bfv = GIN(A, I_BF)[l * 8 + (F.lane & 7)];
    for (int m = gw; m < MALL; m += NGW) {
        f32x4 x[4];
#pragma unroll
        for (int j = 0; j < 4; ++j) x[j] = *((const GAS f32x4*)(XF + (size_t)m * DM) + F.lane + 64 * j);
        float z = 0.f;
#pragma unroll
        for (int h = 0; h < 8; ++h) { float s = 0.f;
#pragma unroll
            for (int j = 0; j < 4; ++j) { const f32x4 w = *((const LAS f32x4*)(wf + h * DM) + F.lane + 64 * j); s += (x[j].x * w.x + x[j].y * w.y) + (x[j].z * w.z + x[j].w * w.w); }
            s = wave_sum(s, F.lane); if ((F.lane & 7) == h) z = s; }
        z += bfv;
        const float lf = fminf(z, 0.f) - log1pf(__expf(-fabsf(z)));
        if (F.lane < 8) { LF[(size_t)m * 8 + F.lane] = lf;
            if (m < MP) GOUT(A)[O_FLP + ((size_t)l * MP + m) * 8 + F.lane] = lf; else GOUT(A)[O_FLS + ((size_t)l * MS + (m - MP)) * 8 + F.lane] = lf; }
    }
    __syncthreads();
}
template <class AP> __device__ __forceinline__ void scan_phase(Frame& F, const AP A, int l) {
    unsigned char* ws = GWS(A); const float* LF = (const float*)(ws + WS_LF); float* CKP = (float*)(ws + WS_CKP); float* CKS = (float*)(ws + WS_CKS); const float* CP = (const float*)(ws + WS_CP);
    const int gw = F.vcu * NWAVES + F.wave, NGW = F.G * NWAVES;
    for (int s = gw; s < 128; s += NGW) {
        if (s < 64) { const int b = s >> 3, h = s & 7; float v[32]; float run = 0.f;
#pragma unroll
            for (int j = 0; j < 32; ++j) { run += LF[((size_t)b * SEQ + F.lane * 32 + j) * 8 + h]; v[j] = run; }
            float tot = run, incl = tot;
#pragma unroll
            for (int o = 1; o < 64; o <<= 1) { const float t = lane_get(incl, (F.lane - o) & 63); if (F.lane >= o) incl += t; }
            const float excl = incl - tot;
#pragma unroll
            for (int j = 0; j < 32; ++j) CKP[(size_t)s * SEQ + F.lane * 32 + j] = -(v[j] + excl) * LOG2E;
        } else { const int bh = s - 64, b = bh >> 3, h = bh & 7;
            float x = F.lane < SSEQ ? LF[((size_t)MP + b * SSEQ + F.lane) * 8 + h] : 0.f, incl = x;
#pragma unroll
            for (int o = 1; o < 16; o <<= 1) { const float t = lane_get(incl, (F.lane - o) & 63); if (F.lane >= o) incl += t; }
            const float base = CP[((size_t)(l * 8 + b) * 8 + h) * PAST + PAST - 1];
            if (F.lane < SSEQ) CKS[bh * SSEQ + F.lane] = -(base + incl) * LOG2E; }
    }
}
template <class AP> __device__ __forceinline__ void diff_finalize(Frame& F, const AP A, int l) {
    unsigned char* ws = GWS(A); const float* O12 = (const float*)(ws + WS_O12); bf16* OB = (bf16*)(ws + WS_OB);
    const int gw = F.vcu * NWAVES + F.wave, NGW = F.G * NWAVES;
    const float li = lambda_init_of(l);
    const float d1 = wave_sum(GIN(A, I_LQ1)[l * 64 + F.lane] * GIN(A, I_LK1)[l * 64 + F.lane], F.lane), d2 = wave_sum(GIN(A, I_LQ2)[l * 64 + F.lane] * GIN(A, I_LK2)[l * 64 + F.lane], F.lane);
    const float lam = __expf(d1) - __expf(d2) + li;
    const int h = F.lane >> 4, e0 = (F.lane & 15) * 8;
    f32x4 g0 = *(const GAS f32x4*)(GIN(A, I_GD) + l * 512 + h * 128 + e0), g1 = *(const GAS f32x4*)(GIN(A, I_GD) + l * 512 + h * 128 + e0 + 4);
    g0 = g0 * (1.0f - li); g1 = g1 * (1.0f - li);
    for (int m = gw; m < MP; m += NGW) {
        const float* o1 = O12 + (size_t)m * DM + (2 * h) * 128 + e0; const float* o2 = o1 + 128;
        f32x4 a0 = *(const GAS f32x4*)o1 - *(const GAS f32x4*)o2 * lam, a1 = *(const GAS f32x4*)(o1 + 4) - *(const GAS f32x4*)(o2 + 4) * lam;
        float ss = (a0.x * a0.x + a0.y * a0.y) + (a0.z * a0.z + a0.w * a0.w) + (a1.x * a1.x + a1.y * a1.y) + (a1.z * a1.z + a1.w * a1.w);
        ss += lane_get(ss, F.lane ^ 1); ss += lane_get(ss, F.lane ^ 2); ss += lane_get(ss, F.lane ^ 4); ss += lane_get(ss, F.lane ^ 8);
        const float r = 1.0f / sqrtf(ss * (1.0f / 128.0f) + RMS_EPS);
        a0 = a0 * r * g0; a1 = a1 * r * g1;
        v4u o; o.x = pk2(a0.x, a0.y); o.y = pk2(a0.z, a0.w); o.z = pk2(a1.x, a1.y); o.w = pk2(a1.z, a1.w);
        *(GAS v4u*)(OB + (size_t)m * 512 + h * 128 + e0) = o;
    }
}
template <class AP> __device__ __forceinline__ void ln_phase(Frame& F, const AP A, const float* g, const float* b, bool write_y) {
    unsigned char* ws = GWS(A); const float* PRE = (const float*)(ws + WS_PRE); float* XF = (float*)(ws + WS_XF); bf16* XB = (bf16*)(ws + WS_XB);
    const int gw = F.vcu * NWAVES + F.wave, NGW = F.G * NWAVES;
    f32x4 gv[4], bv[4];
#pragma unroll
    for (int j = 0; j < 4; ++j) { gv[j] = *((const GAS f32x4*)g + F.lane + 64 * j); bv[j] = *((const GAS f32x4*)b + F.lane + 64 * j); }
    for (int m = gw; m < MALL; m += NGW) {
        f32x4 v[4]; float s = 0.f;
#pragma unroll
        for (int j = 0; j < 4; ++j) { v[j] = *((const GAS f32x4*)(PRE + (size_t)m * DM) + F.lane + 64 * j); s += (v[j].x + v[j].y) + (v[j].z + v[j].w); }
        const float mean = wave_sum(s, F.lane) * (1.f / DM); float s2 = 0.f;
#pragma unroll
        for (int j = 0; j < 4; ++j) { v[j] = v[j] - mean; s2 += (v[j].x * v[j].x + v[j].y * v[j].y) + (v[j].z * v[j].z + v[j].w * v[j].w); }
        const float rstd = 1.f / sqrtf(wave_sum(s2, F.lane) * (1.f / DM) + LN_EPS);
        float* y = write_y ? (m < MP ? GOUT(A) + O_YP + (size_t)m * DM : GOUT(A) + O_YS + (size_t)(m - MP) * DM) : nullptr;
#pragma unroll
        for (int j = 0; j < 4; ++j) { const f32x4 o = v[j] * rstd * gv[j] + bv[j];
            *((GAS f32x4*)(XF + (size_t)m * DM) + F.lane + 64 * j) = o;
            *((GAS unsigned long long*)(XB + (size_t)m * DM) + F.lane + 64 * j) = (unsigned long long)pk2(o.x, o.y) | ((unsigned long long)pk2(o.z, o.w) << 32);
            if (y) *((GAS f32x4*)y + F.lane + 64 * j) = o; }
    }
}
namespace attn_body {
using bf16=__hip_bfloat16;
using bf16x8=__attribute__((ext_vector_type(8)))short;
using s16x4=__attribute__((ext_vector_type(4)))short;
using f32x16=__attribute__((ext_vector_type(16)))float;
using u32x4=__attribute__((ext_vector_type(4)))unsigned;
typedef float f32x4_t __attribute__((ext_vector_type(4)));
constexpr int BATCH=8,SEQ=2048,D=64,DM=512;
constexpr int NW=8,QBLK=32,QB=QBLK*NW,KVBLK=64,NQB=SEQ/QB;
constexpr int ATTN_PITCH=DM, ATTN_UNIT_ROWS=QB;
__device__ __forceinline__ int crow(int r,int hi){return (r&3)+8*(r>>2)+4*hi;}
#define SBAR() __builtin_amdgcn_sched_barrier(0)
__device__ __forceinline__ void cmask(f32x16&p0,f32x16&p1,int jb,int qrel,int hi){
  const float NEG=-INFINITY; int kb=64*jb+4*hi;
  #pragma unroll
  for(int r=0;r<16;++r){int kv=kb+(r&3)+8*(r>>2); if(kv>qrel)p0[r]=NEG; if(kv+32>qrel)p1[r]=NEG;}
}

__device__ __forceinline__ void cmask_diff(f32x16&p0,f32x16&p1,int jb,int qrel,int hi,int cw,float s2x2){
  if(jb>cw){ const float NEG=-INFINITY;
    #pragma unroll
    for(int r=0;r<16;++r){p0[r]=NEG;p1[r]=NEG;} }
  else if(jb==cw){ int kb=64*jb+4*hi-qrel; asm volatile("":"+v"(kb));
    #pragma unroll
    for(int r=0;r<16;++r){const int dk=kb+(r&3)+8*(r>>2); p0[r]-=s2x2*(float)max(dk,0); p1[r]-=s2x2*(float)max(dk+32,0);} }
}
constexpr int NSLOT=3, SLOTB=8192;
constexpr int LDS_K=0, LDS_V=NSLOT*SLOTB, LDS_WS=2*NSLOT*SLOTB, LDS_OST=LDS_WS+NW*64*4, LDS_TBL=LDS_OST+NW*4096, LDS_BYTES=LDS_TBL+SEQ*4;
constexpr float C2=0.125f*1.4426950408889634f;
__device__ __forceinline__ void glds16(const void*gbase,unsigned voff,unsigned lds_dst){unsigned keep;
  asm volatile("s_mov_b32 %0, m0\n\ts_mov_b32 m0, %3\n\ts_nop 0\n\tglobal_load_lds_dwordx4 %1, %2\n\ts_mov_b32 m0, %0":"=&s"(keep):"v"(voff),"s"(gbase),"s"(lds_dst):"memory");}
__device__ __forceinline__ float max3f(float a,float b,float c){float r;asm("v_max3_f32 %0, %1, %2, %3":"=v"(r):"v"(a),"v"(b),"v"(c));return r;}
__device__ __forceinline__ float max2f(float a,float b){float r;asm("v_max_f32_e32 %0, %1, %2":"=v"(r):"v"(a),"v"(b));return r;}
__device__ __forceinline__ float fadd_s(float a,float b){float r;asm("v_add_f32_e32 %0, %1, %2":"=v"(r):"v"(a),"v"(b));return r;}
__device__ __forceinline__ float fsub_s(float a,float b){float r;asm("v_sub_f32_e32 %0, %1, %2":"=v"(r):"v"(a),"v"(b));return r;}
typedef float f32x2_t __attribute__((ext_vector_type(2))); typedef __bf16 bf16x2_t __attribute__((ext_vector_type(2)));
__device__ __forceinline__ unsigned cvtpk_s(float lo,float hi){f32x2_t v={lo,hi};bf16x2_t b=__builtin_convertvector(v,bf16x2_t);return __builtin_bit_cast(unsigned,b);}
#define WAIT_BAR(N) asm volatile("s_waitcnt vmcnt(" #N ") lgkmcnt(0)\n\ts_barrier":::"memory")

__device__ __forceinline__ void qkt(f32x16&p0,f32x16&p1,const char*Kslot,const bf16x8*qr,const f32x16&negm,int r32,int hi){
  const char*kb=Kslot+hi*1024+r32*16;
  #pragma unroll
  for(int d0=0;d0<4;++d0){
    const bf16x8 b0=*reinterpret_cast<const bf16x8*>(kb+d0*2048);
    const bf16x8 b1=*reinterpret_cast<const bf16x8*>(kb+d0*2048+512);
    if(d0==0){p0=__builtin_amdgcn_mfma_f32_32x32x16_bf16(b0,qr[0],negm,0,0,0);p1=__builtin_amdgcn_mfma_f32_32x32x16_bf16(b1,qr[0],negm,0,0,0);}
    else{p0=__builtin_amdgcn_mfma_f32_32x32x16_bf16(b0,qr[d0],p0,0,0,0);p1=__builtin_amdgcn_mfma_f32_32x32x16_bf16(b1,qr[d0],p1,0,0,0);}}
}
typedef __attribute__((address_space(3))) const char* lds_cptr;
typedef short v4i16_t __attribute__((ext_vector_type(4)));
__device__ __forceinline__ void kload8(bf16x8*kf,lds_cptr kp){
  kf[0]=*(const __attribute__((address_space(3))) bf16x8*)(kp);      kf[1]=*(const __attribute__((address_space(3))) bf16x8*)(kp+512);
  kf[2]=*(const __attribute__((address_space(3))) bf16x8*)(kp+2048); kf[3]=*(const __attribute__((address_space(3))) bf16x8*)(kp+2560);
  kf[4]=*(const __attribute__((address_space(3))) bf16x8*)(kp+4096); kf[5]=*(const __attribute__((address_space(3))) bf16x8*)(kp+4608);
  kf[6]=*(const __attribute__((address_space(3))) bf16x8*)(kp+6144); kf[7]=*(const __attribute__((address_space(3))) bf16x8*)(kp+6656);
}
__device__ __forceinline__ void kload2(bf16x8*kf,lds_cptr kp,int j){ kf[2*j]=*(const __attribute__((address_space(3))) bf16x8*)(kp+j*2048); kf[2*j+1]=*(const __attribute__((address_space(3))) bf16x8*)(kp+j*2048+512); }
__device__ __forceinline__ s16x4 vtr(lds_cptr p){ return __builtin_bit_cast(s16x4,__builtin_amdgcn_ds_read_tr16_b64_v4i16((__attribute__((address_space(3))) v4i16_t*)p)); }
__device__ __forceinline__ float rowmax(const f32x16&p0,const f32x16&p1){
  float a=max3f(p0[0],p0[1],p1[0]),b=max3f(p0[2],p0[3],p1[1]);a=max3f(a,p1[2],p1[3]);
  #pragma unroll
  for(int r=4;r<16;r+=4){a=max3f(a,p0[r],p0[r+1]);b=max3f(b,p0[r+2],p0[r+3]);a=max3f(a,p1[r],p1[r+1]);b=max3f(b,p1[r+2],p1[r+3]);}
  const float m=max2f(a,b);
  auto rr=__builtin_amdgcn_permlane32_swap(__float_as_uint(m),__float_as_uint(m),false,false);
  return max2f(__uint_as_float(rr[0]),__uint_as_float(rr[1]));
}
__device__ __forceinline__ void pv(f32x16*o,int vb,bf16x8 pa0,bf16x8 pa1,bf16x8 pa2,bf16x8 pa3){
  #pragma unroll
  for(int d0=0;d0<2;++d0){s16x4 lo[4],hi[4];
    #pragma unroll
    for(int ks=0;ks<4;++ks){
      asm volatile("ds_read_b64_tr_b16 %0,%1 offset:%c2":"=&v"(lo[ks]):"v"(vb),"i"(d0*4096+ks*1024):"memory");
      asm volatile("ds_read_b64_tr_b16 %0,%1 offset:%c2":"=&v"(hi[ks]):"v"(vb),"i"(d0*4096+ks*1024+512):"memory");}
    asm volatile("s_waitcnt lgkmcnt(0)":::"memory");SBAR();
    #define PK(k) (bf16x8){lo[k][0],lo[k][1],lo[k][2],lo[k][3],hi[k][0],hi[k][1],hi[k][2],hi[k][3]}
    o[d0]=__builtin_amdgcn_mfma_f32_32x32x16_bf16(pa0,PK(0),o[d0],0,0,0);
    o[d0]=__builtin_amdgcn_mfma_f32_32x32x16_bf16(pa1,PK(1),o[d0],0,0,0);
    o[d0]=__builtin_amdgcn_mfma_f32_32x32x16_bf16(pa2,PK(2),o[d0],0,0,0);
    o[d0]=__builtin_amdgcn_mfma_f32_32x32x16_bf16(pa3,PK(3),o[d0],0,0,0);
    #undef PK
  }
}

#ifndef ATTN_STORE16
#define ATTN_STORE16(p,v) (*(u32x4*)(p)=(v))
#endif
__device__ __forceinline__ int fresh_lane(){ int l_; asm volatile("v_mbcnt_lo_u32_b32 %0, -1, 0\n\tv_mbcnt_hi_u32_b32 %0, -1, %0":"=v"(l_)); return l_; }
template<int MODE,int THRL> __device__ __forceinline__ void attn_unit(int b,int qb,const bf16*Q,const bf16*__restrict__ K,const bf16*__restrict__ V,void*O,const float*__restrict__ tblsrc,float slope2,char*shm,int wid){
  const int lane=fresh_lane(),tid=wid*64+lane,r32=lane&31,hi=lane>>5;
  const long rowbase=(long)b*SEQ; const int q0=qb*QB;
  const bf16*Qw=Q+(rowbase+q0+wid*QBLK)*DM;
  const bf16*Kh=K+rowbase*DM,*Vh=V+rowbase*DM;
  const lds_cptr shm3=(lds_cptr)shm;
  typedef __attribute__((address_space(3))) float* lds_fptr; typedef __attribute__((address_space(3))) const f32x4_t* lds_f4ptr;
  const unsigned lds0=(unsigned)(uintptr_t)shm;
  float*wsf=(float*)(shm+LDS_WS)+wid*64;
  const lds_fptr wsfu=(lds_fptr)(shm3+LDS_WS)+wid*64;
  const unsigned ksrc=(unsigned)(lane*DM+wid*8)*2u;
  const unsigned vsrc=(unsigned)((16*(wid&3)+(lane>>2))*DM+(wid>>2)*32+(lane&3)*8)*2u;
  const unsigned kdst=lds0+LDS_K+wid*1024, vdst=lds0+LDS_V+wid*1024;
  #define DMA_K(t,slot) glds16(Kh+(long)(t)*KVBLK*DM,ksrc,(unsigned)__builtin_amdgcn_readfirstlane(kdst+(slot)))
  #define DMA_V(t,slot) glds16(Vh+(long)(t)*KVBLK*DM,vsrc,(unsigned)__builtin_amdgcn_readfirstlane(vdst+(slot)))
  const int vb0=(int)(lds0+LDS_V)+((lane>>4)&1)*32+(lane&3)*8+(4*hi+((lane&15)>>2))*64;
  const char*Kbase=shm+LDS_K; bf16x8 kf[8];
  const lds_cptr kp0=shm3+LDS_K+hi*1024+r32*16; const lds_cptr vp0=shm3+LDS_V+((lane>>4)&1)*32+(lane&3)*8+(4*hi+((lane&15)>>2))*64;
  const int NT=(q0+QB)/KVBLK;
  DMA_K(0,0);DMA_V(0,0);DMA_K(1,SLOTB);
  const lds_fptr tbl=(lds_fptr)(shm3+LDS_TBL);
  for(int k=tid;k<q0+QB;k+=NW*64) tbl[k]=(MODE==0)?tblsrc[k]:slope2*(float)k;
  const float kbq=(MODE==0)?tblsrc[q0+wid*QBLK+r32]:slope2*(float)(q0+wid*QBLK+r32);
  const lds_f4ptr tb4=(lds_f4ptr)(shm3+LDS_TBL+16*hi);
  bf16x8 qr[4];
  #pragma unroll
  for(int d0=0;d0<4;++d0)qr[d0]=*reinterpret_cast<const bf16x8*>(&Qw[(long)r32*DM+d0*16+hi*8]);
  float mhat=0.f,l_reg=0.f;f32x16 o[2];o[0]=f32x16{};o[1]=f32x16{};const f32x16 zero16=f32x16{};
  const int qrel=wid*QBLK+r32;
  const int cw=wid>>1; const float s2x2=2.f*slope2;
  #define CMASK(P0,P1,t) do{int jb_=(t)-(NT-4); if(jb_>=0){ if(MODE==0)cmask(P0,P1,jb_,qrel,hi); else cmask_diff(P0,P1,jb_,qrel,hi,cw,s2x2);} }while(0)
  #define PIN(x) asm volatile("":"+v"(x))
  #define CINIT(C0,C1,t) do{ const lds_f4ptr tp_=tb4+(t)*16; \
    _Pragma("unroll") for(int g_=0;g_<4;++g_){ const f32x4_t a_=tp_[2*g_]; \
      _Pragma("unroll") for(int e_=0;e_<4;++e_) C0[4*g_+e_]=a_[e_]-mhat; } \
    PIN(C0); SBAR(); \
    _Pragma("unroll") for(int g_=0;g_<4;++g_){ const f32x4_t b_=tp_[8+2*g_]; \
      _Pragma("unroll") for(int e_=0;e_<4;++e_) C1[4*g_+e_]=b_[e_]-mhat; } \
    PIN(C1); }while(0)
  bool resc=false;
  #define START(P0,P1) do{ const float rm=rowmax(P0,P1); resc=false; \
    { mhat=rm+kbq; f32x16 c0_,c1_; CINIT(c0_,c1_,0); \
      _Pragma("unroll") for(int r=0;r<16;++r){P0[r]+=c0_[r];P1[r]+=c1_[r];} } \
    _Pragma("unroll") for(int r=0;r<16;++r)P0[r]=__builtin_amdgcn_exp2f(P0[r]); }while(0)
  #define RESC() do{ if(resc){ asm volatile("s_waitcnt lgkmcnt(0)":::"memory"); \
      _Pragma("unroll") for(int d_=0;d_<2;++d_) _Pragma("unroll") for(int r=0;r<16;++r)o[d_][r]*=wsf[crow(r,hi)]; } }while(0)
  f32x16 pA0,pA1,pB0,pB1;
  int sl_prev=0,sl_cur=0,sl_next=SLOTB;
  #define ROT() do{sl_prev=sl_cur;sl_cur=sl_next;sl_next=(sl_next==(NSLOT-1)*SLOTB)?0:sl_next+SLOTB;}while(0)
  DMA_K(2,2*SLOTB);
  WAIT_BAR(3);
  qkt(pA0,pA1,Kbase,qr,zero16,r32,hi);asm volatile("s_nop 15\n\ts_nop 7":"+v"(pA0),"+v"(pA1));CMASK(pA0,pA1,0);
  START(pA0,pA1);
  _Pragma("unroll") for(int r=0;r<16;++r)pA1[r]=__builtin_amdgcn_exp2f(pA1[r]);
  WAIT_BAR(0);
  DMA_K(3,0);DMA_V(1,SLOTB);
  ROT();
  kload8(kf,kp0+sl_cur);
  WAIT_BAR(2);
  s16x4 vlo[8],vhi[8]; u32x4 pw0,pw1,pw2,pw3;
  #define PKW(P,B) cvtpk_s(P[B],P[B+1])
  #define PAF(k) __builtin_bit_cast(bf16x8,pw##k)
  #define VFR(i) (bf16x8){vlo[i][0],vlo[i][1],vlo[i][2],vlo[i][3],vhi[i][0],vhi[i][1],vhi[i][2],vhi[i][3]}
  #define MX3(a,b,c) __builtin_fmaxf(__builtin_fmaxf((a),(b)),(c))
  #define GAPA(MF,A0,A1,A2,A3,W0,W1,PW) do{ MF; sacc+=A0; sacc+=A1; sacc+=A2; sacc+=A3; PIN(sacc); W0; W1; PIN(PW); SBAR(); }while(0)
  #define EX(v) __builtin_amdgcn_exp2f(v)
  #define GAPB(MF,X,B) do{ MF; X[B]=EX(X[B]); X[B+1]=EX(X[B+1]); X[B+2]=EX(X[B+2]); X[B+3]=EX(X[B+3]); PIN(X); SBAR(); }while(0)
  #define VRD(i) do{ vlo[i]=vtr(vp_+(((i)>>2)*4096+((i)&3)*1024)); vhi[i]=vtr(vp_+(((i)>>2)*4096+((i)&3)*1024+512)); }while(0)
  #define KRD(G,j) do{ if(G){ kload2(kf,kp0+sl_next,j); SBAR(); } }while(0)
  #define STEP(C0,C1,P0,P1,t,GK,GV,GL) do{ SBAR(); \
    CINIT(C0,C1,t); SBAR(); \
    const lds_cptr vp_=vp0+sl_prev; \
    VRD(0); SBAR(); float sacc=(P0[0]+P0[1]); \
    GAPA(C0=__builtin_amdgcn_mfma_f32_32x32x16_bf16(kf[0],qr[0],C0,0,0,0), P0[2],P0[3],P0[4],P0[5],     pw0[0]=PKW(P0,0), pw0[1]=PKW(P0,2), pw0); \
    VRD(4); SBAR(); GAPA(C1=__builtin_amdgcn_mfma_f32_32x32x16_bf16(kf[1],qr[0],C1,0,0,0), P0[6],P0[7],P0[8],P0[9],     pw0[2]=PKW(P0,4), pw0[3]=PKW(P0,6), pw0); \
    VRD(1); SBAR(); GAPA(C0=__builtin_amdgcn_mfma_f32_32x32x16_bf16(kf[2],qr[1],C0,0,0,0),   P0[10],P0[11],P0[12],P0[13], pw1[0]=PKW(P0,8), pw1[1]=PKW(P0,10), pw1); \
    VRD(5); SBAR(); GAPA(C1=__builtin_amdgcn_mfma_f32_32x32x16_bf16(kf[3],qr[1],C1,0,0,0),   P0[14],P0[15],P1[0],P1[1],   pw1[2]=PKW(P0,12),pw1[3]=PKW(P0,14), pw1); \
    VRD(2); SBAR(); GAPA(C0=__builtin_amdgcn_mfma_f32_32x32x16_bf16(kf[4],qr[2],C0,0,0,0),   P1[2],P1[3],P1[4],P1[5],     pw2[0]=PKW(P1,0), pw2[1]=PKW(P1,2), pw2); \
    VRD(6); SBAR(); GAPA(C1=__builtin_amdgcn_mfma_f32_32x32x16_bf16(kf[5],qr[2],C1,0,0,0),   P1[6],P1[7],P1[8],P1[9],     pw2[2]=PKW(P1,4), pw2[3]=PKW(P1,6), pw2); \
    VRD(3); SBAR(); GAPA(C0=__builtin_amdgcn_mfma_f32_32x32x16_bf16(kf[6],qr[3],C0,0,0,0),   P1[10],P1[11],P1[12],P1[13], pw3[0]=PKW(P1,8), pw3[1]=PKW(P1,10), pw3); \
    VRD(7); SBAR(); GAPA(C1=__builtin_amdgcn_mfma_f32_32x32x16_bf16(kf[7],qr[3],C1,0,0,0),   P1[14],P1[15],0.f,0.f,       pw3[2]=PKW(P1,12),pw3[3]=PKW(P1,14), pw3); \
    l_reg+=sacc; \
    if(GK){DMA_K((t)+3,sl_cur);} if(GV){DMA_V((t)+1,sl_next);} \
    CMASK(C0,C1,t); \
    { float a=MX3(C0[0],C0[1],C1[0]),b=MX3(C0[2],C0[3],C1[1]); a=MX3(a,C1[2],C1[3]); \
      _Pragma("unroll") for(int r=4;r<16;r+=4){a=MX3(a,C0[r],C0[r+1]);b=MX3(b,C0[r+2],C0[r+3]);a=MX3(a,C1[r],C1[r+1]);b=MX3(b,C1[r+2],C1[r+3]);} \
      float rm=__builtin_fmaxf(a,b); { auto rr=__builtin_amdgcn_permlane32_swap(__float_as_uint(rm),__float_as_uint(rm),false,false); rm=__builtin_fmaxf(__uint_as_float(rr[0]),__uint_as_float(rr[1])); } \
      resc=false; \
      if(__builtin_expect(__any(rm>(float)THRL),0)){ const float dl=__builtin_fmaxf(rm,0.f); mhat+=dl; \
        _Pragma("unroll") for(int r=0;r<16;++r){C0[r]-=dl;C1[r]-=dl;} \
        const float f=__builtin_amdgcn_exp2f(-dl); l_reg*=f; { const int ln_=fresh_lane(); if(ln_<32)wsfu[ln_]=f; } resc=true; } } \
    SBAR(); \
    GAPB(o[0]=__builtin_amdgcn_mfma_f32_32x32x16_bf16(PAF(0),VFR(0),o[0],0,0,0), C0,0); \
    GAPB(o[1]=__builtin_amdgcn_mfma_f32_32x32x16_bf16(PAF(0),VFR(4),o[1],0,0,0), C0,4); \
    KRD(GL,0); GAPB(o[0]=__builtin_amdgcn_mfma_f32_32x32x16_bf16(PAF(1),VFR(1),o[0],0,0,0), C0,8); \
    KRD(GL,1); GAPB(o[1]=__builtin_amdgcn_mfma_f32_32x32x16_bf16(PAF(1),VFR(5),o[1],0,0,0), C0,12); \
    KRD(GL,2); GAPB(o[0]=__builtin_amdgcn_mfma_f32_32x32x16_bf16(PAF(2),VFR(2),o[0],0,0,0), C1,0); \
    KRD(GL,3); GAPB(o[1]=__builtin_amdgcn_mfma_f32_32x32x16_bf16(PAF(2),VFR(6),o[1],0,0,0), C1,4); \
    GAPB(o[0]=__builtin_amdgcn_mfma_f32_32x32x16_bf16(PAF(3),VFR(3),o[0],0,0,0), C1,8); \
    GAPB(o[1]=__builtin_amdgcn_mfma_f32_32x32x16_bf16(PAF(3),VFR(7),o[1],0,0,0), C1,12); \
    }while(0)
  int t=1;
  #undef CMASK
  #define CMASK(P0,P1,t) do{}while(0)
  for(;t+5<NT;t+=2){
    STEP(pB0,pB1,pA0,pA1,t,true,true,true);     WAIT_BAR(2); RESC(); ROT();
    STEP(pA0,pA1,pB0,pB1,t+1,true,true,true);   WAIT_BAR(2); RESC(); ROT();
  }
  #undef CMASK
  #define CMASK(P0,P1,t) do{int jb_=(t)-(NT-4); if(jb_>=0){ if(MODE==0)cmask(P0,P1,jb_,qrel,hi); else cmask_diff(P0,P1,jb_,qrel,hi,cw,s2x2);} }while(0)
  #define ENDW(tt) do{ if((tt)+3<NT){WAIT_BAR(2);} else if((tt)+2<NT){WAIT_BAR(1);} else {WAIT_BAR(0);} }while(0)
  for(;t+1<NT;t+=2){
    STEP(pB0,pB1,pA0,pA1,t,(t+3<NT),(t+1<NT),(t+1<NT));       ENDW(t);   RESC(); ROT();
    STEP(pA0,pA1,pB0,pB1,t+1,(t+4<NT),(t+2<NT),(t+2<NT));     ENDW(t+1); RESC(); ROT();
  }
  STEP(pB0,pB1,pA0,pA1,NT-1,false,false,false); RESC();
  { float sacc=pB0[0]+pB0[1]; _Pragma("unroll") for(int r=2;r<16;++r)sacc+=pB0[r]; _Pragma("unroll") for(int r=0;r<16;++r)sacc+=pB1[r]; l_reg+=sacc;
    pw0=(u32x4){PKW(pB0,0),PKW(pB0,2),PKW(pB0,4),PKW(pB0,6)};pw1=(u32x4){PKW(pB0,8),PKW(pB0,10),PKW(pB0,12),PKW(pB0,14)};pw2=(u32x4){PKW(pB1,0),PKW(pB1,2),PKW(pB1,4),PKW(pB1,6)};pw3=(u32x4){PKW(pB1,8),PKW(pB1,10),PKW(pB1,12),PKW(pB1,14)};
    SBAR(); pv(o,vb0+sl_cur,PAF(0),PAF(1),PAF(2),PAF(3)); }
  #undef PKW
  #undef PAF
  #undef VFR
  #undef PIN
  #undef MX3
  #undef GAPA
  #undef GAPB
  #undef EX
  #undef VRD
  #undef KRD
  #undef STEP
  #undef ENDW
  {auto rr=__builtin_amdgcn_permlane32_swap(__float_as_uint(l_reg),__float_as_uint(l_reg),false,false);l_reg=__uint_as_float(rr[0])+__uint_as_float(rr[1]);}
  const int lane_e=fresh_lane(),r32_e=lane_e&31,hi_e=lane_e>>5;
  if(hi_e==0)wsfu[32+r32_e]=l_reg;asm volatile("s_waitcnt lgkmcnt(0)":::"memory");
  float rli[16];
  #pragma unroll
  for(int r=0;r<16;++r)rli[r]=__builtin_amdgcn_rcpf(wsfu[32+crow(r,hi_e)]);
  if(MODE==1){ typedef __attribute__((address_space(1))) float* gfptr; gfptr Of=(gfptr)((float*)O+(rowbase+q0+wid*QBLK+4*hi_e)*1024+r32_e);
    #pragma unroll
    for(int r=0;r<16;++r){ asm volatile("":"+v"(Of)); Of[0]=o[0][r]*rli[r]; Of[32]=o[1][r]*rli[r]; Of+=((r&3)==3)?5*1024:1024; } }
  else{ bf16*Ow=(bf16*)O+(rowbase+q0+wid*QBLK)*DM;
    bf16*stg=(bf16*)(shm+LDS_OST)+wid*2048;
    #pragma unroll
    for(int r=0;r<16;++r){const int orow=crow(r,hi_e);
      #pragma unroll
      for(int d0=0;d0<2;++d0)stg[orow*64+d0*32+r32_e]=__float2bfloat16(o[d0][r]*rli[r]);}
    asm volatile("s_waitcnt lgkmcnt(0)":::"memory");
    #pragma unroll
    for(int i=0;i<4;++i){const int row=i*8+(lane_e>>3),ch=lane_e&7; const u32x4 v=*(const u32x4*)(stg+row*64+ch*8); ATTN_STORE16(Ow+(long)row*DM+ch*8,v);} }
  asm volatile("s_waitcnt lgkmcnt(0)\n\ts_barrier":::"memory");
  #undef DMA_K
  #undef DMA_V
  #undef CMASK
  #undef CINIT
  #undef START
  #undef RESC
  #undef ROT
}
constexpr int ATTN_LDS_BYTES=LDS_BYTES;
#undef SBAR
#undef WAIT_BAR
}
constexpr int SA_NCH = 17;
constexpr size_t WS_PARTF = WS_END;
constexpr size_t WS_PARTD = WS_PARTF + (size_t)64 * SA_NCH * 16 * 66 * 4;
constexpr size_t WS_END2 = WS_PARTD + (size_t)64 * SA_NCH * 16 * 130 * 4;
typedef short sbf16x8 __attribute__((ext_vector_type(8)));
__device__ __forceinline__ sbf16x8 cvt8(const f32x4 a, const f32x4 b) { v4u w; w.x = pg8::cvt_pk_bf16(a.x, a.y); w.y = pg8::cvt_pk_bf16(a.z, a.w); w.z = pg8::cvt_pk_bf16(b.x, b.y); w.w = pg8::cvt_pk_bf16(b.z, b.w); return __builtin_bit_cast(sbf16x8, w); }
template <int KIND  , class AP> __device__ __forceinline__ void sample_attn_unit(Frame& F, const AP A, int l, int b, int h, int chunk) {
    constexpr int NC = KIND ? 2 : 1, VD = KIND ? 128 : 64, NDT = VD / 16, PW = VD + 2;
    unsigned char* ws = GWS(A);
    const int lane = F.lane, g = lane >> 4, n = lane & 15, wid = F.wave;
    const bool isnew = chunk == 16, active = !isnew || wid == 0;
    const int kbase = isnew ? 0 : chunk * 256 + wid * 32;
    const bf16* Qb = (const bf16*)(ws + (KIND ? WS_QB : WS_QA)) + (size_t)(MP + b * SSEQ + n) * 512 + (KIND ? h * 128 : h * 64) + 8 * g;
    const float* Kc = GIN(A, KIND ? I_CDK : I_CFK) + ((size_t)(l * SBATCH + b) * PAST) * 512 + (KIND ? h * 128 : h * 64);
    const float* Vc = GIN(A, KIND ? I_CDV : I_CFV) + ((size_t)(l * SBATCH + b) * PAST) * 512 + (KIND ? h * 128 : h * 64);
    const bf16* Kn = (const bf16*)(ws + (KIND ? WS_KB : WS_KA)) + (size_t)(MP + b * SSEQ) * 512 + (KIND ? h * 128 : h * 64);
    const bf16* Vn = (const bf16*)(ws + (KIND ? WS_VB : WS_VA)) + (size_t)(MP + b * SSEQ) * 512 + (KIND ? h * 128 : h * 64);
    const float slope2 = exp2f(-2.0f * (float)(h + 1)) * LOG2E;
    f32x4 oT[NC][NDT]; float mw[NC], lw[NC];
#pragma unroll
    for (int c = 0; c < NC; ++c) { mw[c] = -1e30f; lw[c] = 0.f;
#pragma unroll
        for (int dt = 0; dt < NDT; ++dt) oT[c][dt] = (f32x4){0.f, 0.f, 0.f, 0.f}; }
    if (active) {
        sbf16x8 pf[NC];
#pragma unroll
        for (int c = 0; c < NC; ++c) {
            f32x4 s[2];
#pragma unroll
            for (int kt = 0; kt < 2; ++kt) { f32x4 acc = (f32x4){0.f, 0.f, 0.f, 0.f};
#pragma unroll
                for (int ks = 0; ks < 2; ++ks) { sbf16x8 kf; const int key = kbase + 16 * kt + n;
                    if (!isnew) { const float* p = Kc + (size_t)key * 512 + c * 64 + 32 * ks + 8 * g; kf = cvt8(*(const GAS f32x4*)p, *(const GAS f32x4*)(p + 4)); }
                    else kf = *(const GAS sbf16x8*)(Kn + (size_t)(key & 15) * 512 + c * 64 + 32 * ks + 8 * g);
                    const sbf16x8 qf = *(const GAS sbf16x8*)(Qb + c * 64 + 32 * ks);
                    acc = __builtin_amdgcn_mfma_f32_16x16x32_bf16(kf, qf, acc, 0, 0, 0); }
                s[kt] = acc; }
            float mx = -1e30f;
#pragma unroll
            for (int kt = 0; kt < 2; ++kt)
#pragma unroll
                for (int i = 0; i < 4; ++i) { const int kk = 16 * kt + 4 * g + i; float bias; bool vis = true;
                    if (KIND == 0) { if (!isnew) bias = -((const float*)(ws + WS_CP))[((size_t)(l * 8 + b) * 8 + h) * PAST + kbase + kk] * LOG2E;
                                     else { bias = ((const float*)(ws + WS_CKS))[(b * 8 + h) * SSEQ + (kk & 15)]; vis = kk <= n; } }
                    else { const int kpos = isnew ? PAST + kk : kbase + kk; bias = -slope2 * fabsf((float)(PAST + n - kpos)); if (isnew) vis = kk < 16; }
                    const float v = vis ? s[kt][i] + bias : -1e30f; s[kt][i] = v; mx = fmaxf(mx, v); }
            mx = fmaxf(mx, lane_get(mx, lane ^ 16)); mx = fmaxf(mx, lane_get(mx, lane ^ 32));
            float sum = 0.f;
#pragma unroll
            for (int kt = 0; kt < 2; ++kt)
#pragma unroll
                for (int i = 0; i < 4; ++i) { const float p = exp2f(s[kt][i] - mx); s[kt][i] = p; sum += p; }
            sum += lane_get(sum, lane ^ 16); sum += lane_get(sum, lane ^ 32);
            mw[c] = mx; lw[c] = sum; pf[c] = cvt8(s[0], s[1]);
        }
#pragma unroll
        for (int dt = 0; dt < NDT; ++dt) { f32x4 v0, v1;
#pragma unroll
            for (int j = 0; j < 4; ++j) { const int k0 = 4 * g + j, k1 = 16 + 4 * g + j;
                if (!isnew) { v0[j] = *(const GAS float*)(Vc + (size_t)(kbase + k0) * 512 + 16 * dt + n); v1[j] = *(const GAS float*)(Vc + (size_t)(kbase + k1) * 512 + 16 * dt + n); }
                else { v0[j] = epi::bf2f(*(const GAS unsigned short*)(Vn + (size_t)(k0 & 15) * 512 + 16 * dt + n)); v1[j] = epi::bf2f(*(const GAS unsigned short*)(Vn + (size_t)(k1 & 15) * 512 + 16 * dt + n)); } }
            const sbf16x8 vf = cvt8(v0, v1);
#pragma unroll
            for (int c = 0; c < NC; ++c) oT[c][dt] = __builtin_amdgcn_mfma_f32_16x16x32_bf16(vf, pf[c], oT[c][dt], 0, 0, 0); }
    }
    LAS float* ML = (LAS float*)(F.lds + RING_OFF); LAS float* OT = ML + 8 * 32;
#pragma unroll
    for (int c = 0; c < NC; ++c) {
        if (g == 0) { ML[wid * 32 + n] = mw[c]; ML[wid * 32 + 16 + n] = lw[c]; }
#pragma unroll
        for (int dt = 0; dt < NDT; ++dt)
#pragma unroll
            for (int i = 0; i < 4; ++i) OT[wid * (VD * 16) + (16 * dt + 4 * g + i) * 16 + n] = oT[c][dt][i];
        __syncthreads();
        float* part = (float*)(ws + (KIND ? WS_PARTD : WS_PARTF)) + ((size_t)((KIND ? ((b * 4 + h) * 2 + c) : (b * 8 + h)) * SA_NCH + chunk) * 16) * PW;
        for (int e = F.tid; e < VD * 16; e += NWAVES * 64) { const int q = e & 15, d = e >> 4; float M = -1e30f;
#pragma unroll
            for (int w = 0; w < 8; ++w) M = fmaxf(M, ML[w * 32 + q]);
            float num = 0.f, L = 0.f;
#pragma unroll
            for (int w = 0; w < 8; ++w) { const float f = exp2f(ML[w * 32 + q] - M); num += f * OT[w * (VD * 16) + e]; L += f * ML[w * 32 + 16 + q]; }
            part[q * PW + 2 + d] = num; if (d == 0) { part[q * PW] = M; part[q * PW + 1] = L; } }
        __syncthreads();
    }
}
template <class AP> __device__ __forceinline__ void sample_attn_phase(Frame& F, const AP A, int l) {
    for (int u = F.vcu; u < 512 + 1024 + 96; u += F.G) {
        if (u < 512) sample_attn_unit<1>(F, A, l, u >> 6, (u >> 4) & 3, u & 15);
        else if (u < 1536) { const int v = u - 512; sample_attn_unit<0>(F, A, l, v >> 7, (v >> 4) & 7, v & 15); }
        else if (u < 1568) { const int v = u - 1536; sample_attn_unit<1>(F, A, l, v >> 2, v & 3, 16); }
        else { const int v = u - 1568; sample_attn_unit<0>(F, A, l, v >> 3, v & 7, 16); }
    }
}
template <class AP> __device__ __forceinline__ void sample_finalize(Frame& F, const AP A, int l) {
    unsigned char* ws = GWS(A);
    const int gw = F.vcu * NWAVES + F.wave, NGW = F.G * NWAVES, lane = F.lane;
    const float li = lambda_init_of(l);
    const float d1 = wave_sum(GIN(A, I_LQ1)[l * 64 + lane] * GIN(A, I_LK1)[l * 64 + lane], lane), d2 = wave_sum(GIN(A, I_LQ2)[l * 64 + lane] * GIN(A, I_LK2)[l * 64 + lane], lane);
    const float lam = __expf(d1) - __expf(d2) + li;
    for (int r = gw; r < MS; r += NGW) { const int b = r >> 4, q = r & 15, row = MP + r;
        {
            const int h = lane >> 3, d0 = (lane & 7) * 8; const float* part = (const float*)(ws + WS_PARTF) + ((size_t)(b * 8 + h) * SA_NCH * 16 + q) * 66;
            float M = -1e30f;
            for (int ch = 0; ch < SA_NCH; ++ch) M = fmaxf(M, part[(size_t)ch * 16 * 66]);
            f32x4 a0 = {0.f, 0.f, 0.f, 0.f}, a1 = a0; float L = 0.f;
            for (int ch = 0; ch < SA_NCH; ++ch) { const float* p = part + (size_t)ch * 16 * 66; const float f = exp2f(p[0] - M); L += f * p[1];
#pragma unroll
                for (int e = 0; e < 4; ++e) { a0[e] += f * p[2 + d0 + e]; a1[e] += f * p[2 + d0 + 4 + e]; } }
            const float inv = 1.0f / L; a0 = a0 * inv; a1 = a1 * inv;
            v4u o; o.x = pk2(a0.x, a0.y); o.y = pk2(a0.z, a0.w); o.z = pk2(a1.x, a1.y); o.w = pk2(a1.z, a1.w);
            *(GAS v4u*)((bf16*)(ws + WS_OA) + (size_t)row * 512 + h * 64 + d0) = o; }
        {
            const int h = lane >> 4, e0 = (lane & 15) * 8; f32x4 oc[2][2];
#pragma unroll
            for (int c = 0; c < 2; ++c) { const float* part = (const float*)(ws + WS_PARTD) + ((size_t)((b * 4 + h) * 2 + c) * SA_NCH * 16 + q) * 130;
                float M = -1e30f;
                for (int ch = 0; ch < SA_NCH; ++ch) M = fmaxf(M, part[(size_t)ch * 16 * 130]);
                f32x4 a0 = {0.f, 0.f, 0.f, 0.f}, a1 = a0; float L = 0.f;
                for (int ch = 0; ch < SA_NCH; ++ch) { const float* p = part + (size_t)ch * 16 * 130; const float f = exp2f(p[0] - M); L += f * p[1];
#pragma unroll
                    for (int e = 0; e < 4; ++e) { a0[e] += f * p[2 + e0 + e]; a1[e] += f * p[2 + e0 + 4 + e]; } }
                const float inv = 1.0f / L; oc[c][0] = a0 * inv; oc[c][1] = a1 * inv; }
            f32x4 g0 = *(const GAS f32x4*)(GIN(A, I_GD) + l * 512 + h * 128 + e0), g1 = *(const GAS f32x4*)(GIN(A, I_GD) + l * 512 + h * 128 + e0 + 4);
            f32x4 a0 = oc[0][0] - oc[1][0] * lam, a1 = oc[0][1] - oc[1][1] * lam;
            float ss = (a0.x * a0.x + a0.y * a0.y) + (a0.z * a0.z + a0.w * a0.w) + (a1.x * a1.x + a1.y * a1.y) + (a1.z * a1.z + a1.w * a1.w);
            ss += lane_get(ss, lane ^ 1); ss += lane_get(ss, lane ^ 2); ss += lane_get(ss, lane ^ 4); ss += lane_get(ss, lane ^ 8);
            const float rr = 1.0f / sqrtf(ss * (1.0f / 128.0f) + RMS_EPS) * (1.0f - li);
            a0 = a0 * rr * g0; a1 = a1 * rr * g1;
            v4u o; o.x = pk2(a0.x, a0.y); o.y = pk2(a0.z, a0.w); o.z = pk2(a1.x, a1.y); o.w = pk2(a1.z, a1.w);
            *(GAS v4u*)((bf16*)(ws + WS_OB) + (size_t)row * 512 + h * 128 + e0) = o; }
    }
}
struct NaiveArgs { const float* in[N_IN]; unsigned char* ws; int layer, sample, mode, pad; };
template <int VD>
__global__ void __launch_bounds__(64) naive_attn(NaiveArgs a) {
    __shared__ float Ks[32][64]; __shared__ float Vs[32][VD]; __shared__ float Bs[32];
    const int tid = threadIdx.x, qblk = blockIdx.x, vh = blockIdx.y, b = blockIdx.z, l = a.layer;
    const bool fox = a.mode == 0; unsigned char* ws = a.ws;
    const int n0 = a.sample ? PAST : 0, nq = a.sample ? SSEQ : 64;
    const int rowb = a.sample ? MP + b * SSEQ : b * SEQ;
    const int qi = qblk * 64 + tid;
    const int qpos = n0 + qi; const bool qact = tid < nq;
    const int n1 = a.sample ? SSEQ : (qblk + 1) * 64;
    const int h = fox ? vh : (vh >> 1), qcol = fox ? h * 64 : h * 128 + (vh & 1) * 64, vcol = fox ? h * 64 : h * 128;
    const bf16* Q = (const bf16*)(ws + (fox ? WS_QA : WS_QB)); const bf16* K1 = (const bf16*)(ws + (fox ? WS_KA : WS_KB)); const bf16* V1 = (const bf16*)(ws + (fox ? WS_VA : WS_VB));
    const float* K0 = a.in[fox ? I_CFK : I_CDK] + (size_t)(l * SBATCH + b) * PAST * 512 + qcol; const float* V0 = a.in[fox ? I_CFV : I_CDV] + (size_t)(l * SBATCH + b) * PAST * 512 + vcol;
    const float* CP = (const float*)(ws + WS_CP) + ((size_t)(l * 8 + b) * 8 + h) * PAST;
    const float* CK1 = a.sample ? (const float*)(ws + WS_CKS) + (b * 8 + h) * SSEQ : (const float*)(ws + WS_CKP) + (size_t)(b * 8 + h) * SEQ;
    const float slope2 = exp2f(-2.0f * (float)(h + 1)) * LOG2E;
    float q[64];
#pragma unroll
    for (int d = 0; d < 64; ++d) q[d] = qact ? epi::bf2f(Q[(size_t)(rowb + qi) * 512 + qcol + d]) : 0.f;
    float o[VD];
#pragma unroll
    for (int e = 0; e < VD; ++e) o[e] = 0.f;
    float mrun = -1e30f, lrun = 0.f;
    const int ntot = n0 + n1;
    for (int k0 = 0; k0 < ntot; k0 += 32) {
        __syncthreads();
        for (int j = 0; j < 32; ++j) { const int k = k0 + j; float kv = 0.f;
            if (k < ntot) kv = k < n0 ? K0[(size_t)k * 512 + tid] : epi::bf2f(K1[(size_t)(rowb + k - n0) * 512 + qcol + tid]);
            Ks[j][tid] = kv;
            for (int e = tid; e < VD; e += 64) { float vv = 0.f; if (k < ntot) vv = k < n0 ? V0[(size_t)k * 512 + e] : epi::bf2f(V1[(size_t)(rowb + k - n0) * 512 + vcol + e]); Vs[j][e] = vv; } }
        if (tid < 32) { const int k = k0 + tid; float bb = 0.f; if (fox && k < ntot) bb = k < n0 ? -CP[k] * LOG2E : CK1[k - n0]; Bs[tid] = bb; }
        __syncthreads();
        float s[32]; float tmax = -1e30f;
#pragma unroll
        for (int j = 0; j < 32; ++j) { const int k = k0 + j; float acc = 0.f;
#pragma unroll
            for (int d = 0; d < 64; ++d) acc += q[d] * Ks[j][d];
            bool vis = k < ntot && (fox ? (k <= qpos) : ((k >> 6) <= (qpos >> 6)));
            acc += fox ? Bs[j] : -slope2 * fabsf((float)(qpos - k));
            s[j] = vis ? acc : -1e30f; tmax = fmaxf(tmax, s[j]); }
        const float mnew = fmaxf(mrun, tmax), sc = exp2f(mrun - mnew);
        lrun *= sc;
#pragma unroll
        for (int e = 0; e < VD; ++e) o[e] *= sc;
#pragma unroll
        for (int j = 0; j < 32; ++j) { const float p = s[j] > -1e29f ? exp2f(s[j] - mnew) : 0.f; lrun += p;
#pragma unroll
            for (int e = 0; e < VD; ++e) o[e] += p * Vs[j][e]; }
        mrun = mnew;
    }
    if (qact) { const float inv = 1.0f / lrun;
        if (fox) { bf16* O = (bf16*)(ws + WS_OA) + (size_t)(rowb + qi) * 512 + h * 64;
#pragma unroll
            for (int e = 0; e < VD; ++e) O[e] = (bf16)f2bf(o[e] * inv);
        } else { float* O = (float*)(ws + WS_O12) + (size_t)(rowb + qi) * DM + vh * 128;
#pragma unroll
            for (int e = 0; e < VD; ++e) O[e] = o[e] * inv; } }
}
__device__ __forceinline__ void prompt_attn_phase(char* lds, unsigned char* ws, int vcu, int G, int wid) {
    typedef attn_body::bf16 abf;
    for (int P = vcu; P < 256; P += G) { const int stream = P >> 2, s = P & 3, b = stream >> 3, h = stream & 7;
        for (int w = 0; w < 2; ++w) attn_body::attn_unit<0, 8>(b, w ? s : 7 - s, (const abf*)(ws + WS_QA) + h * 64, (const abf*)(ws + WS_KA) + h * 64, (const abf*)(ws + WS_VA) + h * 64, (abf*)(ws + WS_OA) + h * 64,
                                                                (const float*)(ws + WS_CKP) + (size_t)stream * SEQ, 0.f, lds, wid); }
    for (int P = vcu; P < 512; P += G) { const int stream = P >> 2, s = P & 3, b = stream >> 4, h = (stream >> 2) & 3, c = (stream >> 1) & 1, vh = stream & 1;
        const float slope2 = exp2f(-2.0f * (float)(h + 1)) * LOG2E;
        for (int w = 0; w < 2; ++w) attn_body::attn_unit<1, 8>(b, w ? s : 7 - s, (const abf*)(ws + WS_QB) + h * 128 + c * 64, (const abf*)(ws + WS_KB) + h * 128 + c * 64, (const abf*)(ws + WS_VB) + h * 128 + vh * 64,
                                                                (float*)(ws + WS_O12) + (h * 2 + c) * 128 + vh * 64, nullptr, slope2, lds, wid); }
}
constexpr int NPH = 12;
constexpr int NPHASES = 1 + DEPTH * NPH;
#ifndef MK_ATTN_NAIVE
#define MK_ATTN_NAIVE 0
#endif
__global__ void __launch_bounds__(NWAVES * 64, 2) mk_fwd(Args args_by_value) {
    typedef __attribute__((address_space(4))) const Args* kargs_t;
    kargs_t ap = (kargs_t)__builtin_amdgcn_kernarg_segment_ptr();
#define args ap
    extern __shared__ __attribute__((aligned(16))) unsigned char lds[];
    Frame F;
    F.lds = (LAS unsigned char*)lds; F.MISC = (volatile LAS unsigned*)(F.lds + MISC_OFF);
    F.tid = threadIdx.x; F.lane = F.tid & 63; F.wave = __builtin_amdgcn_readfirstlane(F.tid >> 6);
    F.G = gridDim.x; { const int bx = blockIdx.x; F.vcu = (F.G % 8 == 0) ? (bx % 8) * (F.G / 8) + bx / 8 : bx; }
    GAS unsigned char* wsg = (GAS unsigned char*)args->ws; unsigned char* ws = (unsigned char*)wsg; F.ctl = (gu32*)(ws + WS_CTL); int bx = blockIdx.x;
    for (int u = F.tid; u < (LDS_BYTES - LDSCTL_OFF) / 4; u += NWAVES * 64) ((LAS unsigned*)(F.lds + LDSCTL_OFF))[u] = 0u;
    __syncthreads();
    const int lo = args->ph_lo, hi = args->ph_hi;
    const bool multi = (hi - lo) > 1;
    XcdBarrier bar; bar.bar = (unsigned*)(F.ctl + CW_BAR); bar.x = 0; bar.st = nullptr;
    if (multi) bar = xcd_barrier_post((unsigned*)(F.ctl + CW_BAR), F.MISC + 8);
#define IN(k) (lo <= (k) && (k) < hi)
#define FRESH() do { int l_; asm volatile("v_mbcnt_lo_u32_b32 %0, -1, 0\n\tv_mbcnt_hi_u32_b32 %0, -1, %0" : "=v"(l_)); F.lane = l_; F.tid = F.wave * 64 + l_; asm volatile("" : "+s"(F.G), "+s"(bx), "+s"(wsg), "+s"(ap)); ws = (unsigned char*)wsg; } while (0)
#define SEAM(k) do { if (IN(k) && IN((k) + 1)) xcd_barrier(bar); } while (0)
    if (IN(0)) { p0_prologue(F, args); SEAM(0); }
    for (int l = 0; l < DEPTH; ++l) {
        const int p0 = 1 + l * NPH;
        unsigned char* wl = ws + WS_W + (size_t)l * WL_SIZE;
        if (IN(p0 + 0)) { FRESH();
            pg8::Gemm g{(const bf16*)(ws + WS_XB), (const bf16*)(wl + WL_IN), MPAD, NPROJ, DM}; pg8::StaticOrder S; S.init(MPAD, NPROJ, F.G, bx);
            epi::FProj f{ws, GOUT(args), l};
            epi::EpiRow8<epi::FProj> E{f};
            pg8::gemm_phase<epi::EpiRow8<epi::FProj>, pg8::StaticOrder, true, true>(F.lds + RING_OFF, g, S, E, F.wave);
            logf_phase(F, args, l);
            SEAM(p0 + 0);
        }
        if (IN(p0 + 1)) { FRESH(); scan_phase(F, args, l); SEAM(p0 + 1); }
        if (IN(p0 + 2)) { FRESH(); prompt_attn_phase((char*)lds + RING_OFF, ws, F.vcu, F.G, F.wave); FRESH(); sample_attn_phase(F, args, l); SEAM(p0 + 2); }
        if (IN(p0 + 3)) { FRESH(); diff_finalize(F, args, l); sample_finalize(F, args, l); SEAM(p0 + 3); }
        if (IN(p0 + 4)) { FRESH();
            pg8::Gemm g{(const bf16*)(ws + WS_OA), (const bf16*)(wl + WL_BA), MPAD, DM, 512}; pg8::StaticOrder S; S.init(MPAD, DM, F.G, bx);
            epi::EpiRow8<epi::FGate1> E{epi::FGate1{(const bf16*)(ws + WS_G), (float*)(ws + WS_T1)}};
            pg8::gemm_phase<epi::EpiRow8<epi::FGate1>, pg8::StaticOrder, true, true>(F.lds + RING_OFF, g, S, E, F.wave);
            SEAM(p0 + 4);
        }
        if (IN(p0 + 5)) { FRESH();
            pg8::Gemm g{(const bf16*)(ws + WS_OB), (const bf16*)(wl + WL_BB), MPAD, DM, 512}; pg8::StaticOrder S; S.init(MPAD, DM, F.G, bx);
            epi::EpiRow8<epi::FGate2> E{epi::FGate2{(const bf16*)(ws + WS_G), (const float*)(ws + WS_T1), (bf16*)(ws + WS_MG)}};
            pg8::gemm_phase<epi::EpiRow8<epi::FGate2>, pg8::StaticOrder, true, true>(F.lds + RING_OFF, g, S, E, F.wave);
            SEAM(p0 + 5);
        }
        if (IN(p0 + 6)) { FRESH();
            pg8::Gemm g{(const bf16*)(ws + WS_MG), (const bf16*)(wl + WL_O), MPAD, DM, DM}; pg8::StaticOrder S; S.init(MPAD, DM, F.G, bx);
            epi::EpiRow8<epi::FRes> E{epi::FRes{(const float*)(ws + WS_XF), nullptr, (float*)(ws + WS_PRE)}};
            pg8::gemm_phase<epi::EpiRow8<epi::FRes>, pg8::StaticOrder, true, true>(F.lds + RING_OFF, g, S, E, F.wave);
            SEAM(p0 + 6);
        }
        if (IN(p0 + 7)) { FRESH(); ln_phase(F, args, GIN(args, I_L1G) + l * DM, GIN(args, I_L1B) + l * DM, false); SEAM(p0 + 7); }
        if (IN(p0 + 8)) { FRESH();
            pg8::Gemm g{(const bf16*)(ws + WS_PB) + (size_t)l * MPAD * PLE, (const bf16*)(wl + WL_PPW), MPAD, DM, PLE}; pg8::StaticOrder S; S.init(MPAD, DM, F.G, bx);
            epi::EpiRow8<epi::FStoreF32> E{epi::FStoreF32{(float*)(ws + WS_PPO)}};
            pg8::gemm_phase<epi::EpiRow8<epi::FStoreF32>, pg8::StaticOrder, true, true>(F.lds + RING_OFF, g, S, E, F.wave);
            SEAM(p0 + 8);
        }
        if (IN(p0 + 9)) { FRESH();
            { pg8::Gemm g{(const bf16*)(ws + WS_XB), (const bf16*)(wl + WL_GU), MPAD, NGU, DM}; pg8::StaticOrder S; S.init(MPAD, NGU, F.G, bx);
              epi::EpiSwiGLU E{(bf16*)(ws + WS_HB), DFF};
              pg8::gemm_phase<epi::EpiSwiGLU, pg8::StaticOrder, true, true>(F.lds + RING_OFF, g, S, E, F.wave); }
            { pg8::Gemm g{(const bf16*)(ws + WS_XB), (const bf16*)(wl + WL_PG), MPAD, DM, DM}; pg8::StaticOrder S; S.init(MPAD, DM, F.G, bx);
              epi::EpiRow8<epi::FPleGate> E{epi::FPleGate{(const float*)(ws + WS_PPO), (float*)(ws + WS_PLE)}};
              pg8::gemm_phase<epi::EpiRow8<epi::FPleGate>, pg8::StaticOrder, true, true>(F.lds + RING_OFF, g, S, E, F.wave); }
            SEAM(p0 + 9);
        }
        if (IN(p0 + 10)) { FRESH();
            pg8::Gemm g{(const bf16*)(ws + WS_HB), (const bf16*)(wl + WL_D), MPAD, DM, DFF}; pg8::StaticOrder S; S.init(MPAD, DM, F.G, bx);
            epi::EpiRow8<epi::FRes> E{epi::FRes{(const float*)(ws + WS_XF), (const float*)(ws + WS_PLE), (float*)(ws + WS_PRE)}};
            pg8::gemm_phase<epi::EpiRow8<epi::FRes>, pg8::StaticOrder, true, true>(F.lds + RING_OFF, g, S, E, F.wave);
            SEAM(p0 + 10);
        }
        if (IN(p0 + 11)) { FRESH(); ln_phase(F, args, GIN(args, I_L2G) + l * DM, GIN(args, I_L2B) + l * DM, l == DEPTH - 1); SEAM(p0 + 11); }
    }
#undef IN
#undef SEAM
#undef args
}

extern "C" void kernel_launch(void* const* d_in, const int* in_sizes, int n_in, void* d_out, int out_size, void* d_ws, size_t ws_size, hipStream_t stream) {
    static int grid = 0;
    if (grid == 0) {
        if (n_in != N_IN || (size_t)out_size != O_END || ws_size < WS_END2) { fprintf(stderr, "kernel_launch: unexpected shapes: n_in %d out %d ws %zu (need %zu)\n", n_in, out_size, ws_size, (size_t)WS_END2); grid = -1; return; }
        int dev = 0, cus = 0, per_cu = 0;
        if (hipGetDevice(&dev) != hipSuccess || hipDeviceGetAttribute(&cus, hipDeviceAttributeMultiprocessorCount, dev) != hipSuccess) { grid = -1; return; }
        if (hipFuncSetAttribute((const void*)mk_fwd, hipFuncAttributeMaxDynamicSharedMemorySize, LDS_BYTES) != hipSuccess) { fprintf(stderr, "kernel_launch: hipFuncSetAttribute failed\n"); grid = -1; return; }
        if (hipOccupancyMaxActiveBlocksPerMultiprocessor(&per_cu, (const void*)mk_fwd, NWAVES * 64, LDS_BYTES) != hipSuccess || per_cu < 1) fprintf(stderr, "kernel_launch: occupancy query says %d\n", per_cu);
        (void)hipGetLastError();
        grid = cus;
    }
    if (grid < 0) return;
    if (hipMemsetAsync((char*)d_ws + WS_CTL, 0, CTL_ZERO_BYTES, stream) != hipSuccess) return;
    Args a{};
    for (int i = 0; i < N_IN; ++i) a.in[i] = (const float*)d_in[i];
    a.out = (float*)d_out; a.ws = (unsigned char*)d_ws;
#if MK_ATTN_NAIVE
    NaiveArgs na{};
    for (int i = 0; i < N_IN; ++i) na.in[i] = (const float*)d_in[i];
    na.ws = (unsigned char*)d_ws;
    for (int ph = 0; ph < NPHASES; ++ph) {
        const int l = (ph - 1) / NPH, p = (ph - 1) % NPH;
        if (ph > 0 && p == 2) {
            na.layer = l;
#if MK_ATTN_NAIVE >= 2
            na.sample = 0; na.mode = 0; hipLaunchKernelGGL(naive_attn<64>, dim3(SEQ / 64, 8, NB), dim3(64), 0, stream, na);
            na.sample = 0; na.mode = 1; hipLaunchKernelGGL(naive_attn<128>, dim3(SEQ / 64, 8, NB), dim3(64), 0, stream, na);
#else
            a.ph_lo = ph; a.ph_hi = ph + 1; hipLaunchKernelGGL(mk_fwd, dim3(grid), dim3(NWAVES * 64), LDS_BYTES, stream, a);
#endif
#if MK_ATTN_NAIVE >= 3
            na.sample = 1; na.mode = 0; hipLaunchKernelGGL(naive_attn<64>, dim3(1, 8, SBATCH), dim3(64), 0, stream, na);
            na.sample = 1; na.mode = 1; hipLaunchKernelGGL(naive_attn<128>, dim3(1, 8, SBATCH), dim3(64), 0, stream, na);
#endif
            continue;
        }
        a.ph_lo = ph; a.ph_hi = ph + 1;
        hipLaunchKernelGGL(mk_fwd, dim3(grid), dim3(NWAVES * 64), LDS_BYTES, stream, a);
    }
#else
    a.ph_lo = 0; a.ph_hi = NPHASES;
    hipLaunchKernelGGL(mk_fwd, dim3(grid), dim3(NWAVES * 64), LDS_BYTES, stream, a);
#endif
    const hipError_t le = hipPeekAtLastError();
    if (le != hipSuccess) fprintf(stderr, "kernel_launch: launch failed: %s\n", hipGetErrorName(le));
}
```

```cpp
#include <hip/hip_runtime.h>
#include <hip/hip_bf16.h>
#include <cstdio>
#include <cstdint>
#include <cmath>
namespace pg8 {
#define PG8_LAS __attribute__((address_space(3)))
typedef unsigned short bf16_t;
typedef short bf16x8 __attribute__((ext_vector_type(8)));
typedef float f32x4 __attribute__((ext_vector_type(4)));
typedef unsigned u32x4 __attribute__((ext_vector_type(4)));
constexpr int BM = 256, BK = 64, HALF = 128, HTB = HALF * BK * 2  , STAGE_BYTES = 8 * HTB, NXCD = 8, WGM = 8;

__host__ __device__ __forceinline__ int lds_byte(int r, int c) { const int st = (r >> 4) * 2 + (c >> 5), rr = r & 15, cc = c & 31, ob = rr * 64 + cc * 2; return st * 1024 + (ob ^ (((ob >> 9) & 1) << 5)); }
__host__ __device__ __forceinline__ void stage_rc(int b, int& R, int& C) { const int st = b / 1024, sb = b % 1024, swz = sb ^ (((sb >> 9) & 1) << 5); R = (st >> 1) * 16 + swz / 64; C = (st & 1) * 32 + (swz % 64) / 2; }
__host__ __device__ __forceinline__ int perm32(int rho) { const int n = rho >> 4, i = rho & 15; return 8 * (i >> 2) + 4 * n + (i & 3); }

struct Unit { int pm, pn; };
struct Gemm { const bf16_t* A; const bf16_t* Bt; int M, N, K; };

struct StaticOrder {
    int nM, nN, nwg, G, c;
    __host__ __device__ void init(int M, int N, int G_, int c_) { nM = M / BM; nN = N / BM; nwg = nM * nN; G = G_; c = c_; }
    __host__ __device__ bool next(int i, Unit& u) const {
        const long L = (long)i * G + c; if (L >= nwg) return false;
        int wgid = (int)L; { const int q = nwg / NXCD, r = nwg % NXCD, xcd = wgid % NXCD, off = wgid / NXCD; wgid = (xcd < r ? xcd * (q + 1) : r * (q + 1) + (xcd - r) * q) + off; }
        const int nig = WGM * nN, gid = wgid / nig, fm = gid * WGM, gsz = (nM - fm) < WGM ? (nM - fm) : WGM;
        u.pm = fm + ((wgid % nig) % gsz); u.pn = (wgid % nig) / gsz; return true;
    }
    __device__ __forceinline__ void a_ready(const Unit&) const {}
    __device__ __forceinline__ void done(const Unit&) const {}
};

__device__ __forceinline__ unsigned cvt_pk_bf16(float lo, float hi) { unsigned r; asm volatile("v_cvt_pk_bf16_f32 %0, %1, %2" : "=v"(r) : "v"(lo), "v"(hi)); return r; }
typedef float f32x2 __attribute__((ext_vector_type(2)));
__device__ __forceinline__ f32x2 gelu_pk(f32x2 v) {
    const f32x2 av = __builtin_elementwise_abs(v), d = av * 0.2316418882f + 1.0f;
    f32x2 t; t.x = __builtin_amdgcn_rcpf(d.x); t.y = __builtin_amdgcn_rcpf(d.y);
    f32x2 q = t * 0.5307027145f + (-0.7265760135f); q = q * t + 0.7107068705f; q = q * t + (-0.142248368f); q = q * t + 0.127414796f; q = q * t;
    const f32x2 s = (v * v) * (-0.72134752044f);
    f32x2 e; e.x = __builtin_amdgcn_exp2f(s.x); e.y = __builtin_amdgcn_exp2f(s.y);
    const f32x2 m = v * (q * e), r = v - m;
    f32x2 o; o.x = v.x < 0.f ? m.x : r.x; o.y = v.y < 0.f ? m.y : r.y; return o;
}

template <int ACT  > struct EpiBf16 {
    static constexpr bool PERM = true, AFTER_DRAIN = false; static_assert(ACT == 0 || ACT == 1, "EpiBf16: ACT is 0 (none) or 1 (gelu_pk)");
    bf16_t* O; int ldc; const float* bias; int split_cols; size_t split_stride; float scale0;
    __device__ __forceinline__ void operator()(const f32x4 (&acc)[2][2][4][2], const Unit& u, int wr, int wc, int fr, int fq) const {
        const int row0 = u.pm * BM + wr * 64 + fr; int colt = u.pn * BM; bf16_t* base = O;
        float sc = 1.f; if (split_cols) { const int t = colt / split_cols; base += (size_t)t * split_stride; colt -= t * split_cols; if (t == 0) sc = scale0; }
        const int col0 = colt + wc * 32 + 8 * fq, bcol0 = u.pn * BM + wc * 32 + 8 * fq;
        f32x4 bv[2][2];
#pragma unroll
        for (int bj = 0; bj < 2; ++bj)
#pragma unroll
            for (int n = 0; n < 2; ++n) bv[bj][n] = bias ? *(const f32x4*)(bias + bcol0 + bj * HALF + 4 * n) : (f32x4){0.f, 0.f, 0.f, 0.f};
#pragma unroll
        for (int ai = 0; ai < 2; ++ai)
#pragma unroll
            for (int m = 0; m < 4; ++m) { bf16_t* rowp = base + (size_t)(row0 + ai * HALF + m * 16) * ldc + col0;
#pragma unroll
                for (int bj = 0; bj < 2; ++bj) { f32x4 v0 = acc[ai][bj][m][0] + bv[bj][0], v1 = acc[ai][bj][m][1] + bv[bj][1];
                    if (ACT == 1) { f32x2 a = gelu_pk((f32x2){v0[0], v0[1]}), b = gelu_pk((f32x2){v0[2], v0[3]}), c = gelu_pk((f32x2){v1[0], v1[1]}), d = gelu_pk((f32x2){v1[2], v1[3]});
                        v0 = (f32x4){a.x, a.y, b.x, b.y}; v1 = (f32x4){c.x, c.y, d.x, d.y}; }
                    v0 = v0 * sc; v1 = v1 * sc; u32x4 w; w.x = cvt_pk_bf16(v0[0], v0[1]); w.y = cvt_pk_bf16(v0[2], v0[3]); w.z = cvt_pk_bf16(v1[0], v1[1]); w.w = cvt_pk_bf16(v1[2], v1[3]);
                    *(u32x4*)(rowp + bj * HALF) = w; } }
    }
};

struct PanelStats {
    unsigned* xbuf;
    unsigned* cnt;
    unsigned* tmo;
    int ntn; float eps;
    unsigned code;
    __device__ __forceinline__ bool run(const f32x4 (&v)[2][2][4][2], const Unit& u, int wr, int wc, int fr, int fq, PG8_LAS unsigned char* lds, int wid, int lane) const {
        typedef float f32x2v __attribute__((ext_vector_type(2)));
        PG8_LAS f32x2v* P = (PG8_LAS f32x2v*)lds;
        PG8_LAS f32x2v* S = (PG8_LAS f32x2v*)(lds + 8192);
        PG8_LAS unsigned* flag = (PG8_LAS unsigned*)(lds + 8192 + 2048);
#pragma unroll
        for (int ai = 0; ai < 2; ++ai)
#pragma unroll
            for (int m = 0; m < 4; ++m) {
                float s = 0.f;
#pragma unroll
                for (int bj = 0; bj < 2; ++bj)
#pragma unroll
                    for (int n = 0; n < 2; ++n) { const f32x4 x = v[ai][bj][m][n]; s += (x[0] + x[1]) + (x[2] + x[3]); }
                s += __shfl_xor(s, 16); s += __shfl_xor(s, 32);
                const float mw = s * (1.0f / 64.0f); float q = 0.f;
#pragma unroll
                for (int bj = 0; bj < 2; ++bj)
#pragma unroll
                    for (int n = 0; n < 2; ++n) { const f32x4 d = v[ai][bj][m][n] - mw; q += (d[0] * d[0] + d[1] * d[1]) + (d[2] * d[2] + d[3] * d[3]); }
                q += __shfl_xor(q, 16); q += __shfl_xor(q, 32);
                if (fq == 0) P[(ai * HALF + wr * 64 + m * 16 + fr) * 4 + wc] = (f32x2v){mw, q};
            }
        asm volatile("s_waitcnt lgkmcnt(0)" ::: "memory"); __builtin_amdgcn_s_barrier(); asm volatile("" ::: "memory");
#if defined(BROKEN_EXCHANGE_NO_WAIT)
#warning BROKEN CONTROL BUILD: the row-statistics exchange does not wait; results are wrong by design
        if (blockIdx.x >= 64) { const long long t0_ = clock64(); while (clock64() - t0_ < 60000) __builtin_amdgcn_s_sleep(8); }
#endif
        const int row = wid * 32 + (lane & 31);
        if (lane < 32) {
            const f32x2v a = P[row * 4 + 0], b = P[row * 4 + 1], c = P[row * 4 + 2], d = P[row * 4 + 3];
            const float mt = (a.x + b.x + c.x + d.x) * 0.25f;
            const float da = a.x - mt, db = b.x - mt, dc = c.x - mt, dd = d.x - mt;
            const float m2 = (a.y + b.y) + (c.y + d.y) + 64.0f * ((da * da + db * db) + (dc * dc + dd * dd));
            unsigned long long* slot = (unsigned long long*)xbuf + ((size_t)(u.pm * BM + row) * 4 + u.pn);
            __hip_atomic_store(slot, ((unsigned long long)__float_as_uint(m2) << 32) | __float_as_uint(mt), __ATOMIC_RELAXED, __HIP_MEMORY_SCOPE_AGENT);
        }
        asm volatile("s_waitcnt vmcnt(0)" ::: "memory");
        if (lane == 0) __hip_atomic_fetch_add(cnt + 64 * u.pm, 1u, __ATOMIC_RELAXED, __HIP_MEMORY_SCOPE_AGENT);
        if (wid == 0) {
            bool dead = false; const unsigned long long t0 = __builtin_amdgcn_s_memrealtime(); const unsigned want = 8u * (unsigned)ntn;
            for (;;) {
#if defined(BROKEN_EXCHANGE_NO_WAIT)
                break;
#endif
                if ((unsigned)__builtin_amdgcn_readfirstlane(__hip_atomic_load(cnt + 64 * u.pm, __ATOMIC_RELAXED, __HIP_MEMORY_SCOPE_AGENT)) >= want) break;
                if (__builtin_amdgcn_s_memrealtime() - t0 > 2000000ull) {
                    if (lane == 0) { unsigned expect = 0u; __hip_atomic_compare_exchange_strong(tmo + 1, &expect, code | (unsigned)(u.pm & 0xff), __ATOMIC_RELAXED, __ATOMIC_RELAXED, __HIP_MEMORY_SCOPE_AGENT);
                                     __hip_atomic_store(tmo, 1u, __ATOMIC_RELAXED, __HIP_MEMORY_SCOPE_AGENT); }
                    dead = true; break; }
                __builtin_amdgcn_s_sleep(2);
            }
            __builtin_amdgcn_fence(__ATOMIC_ACQUIRE, "agent");
            if (lane == 0) flag[0] = dead ? 1u : 0u;
        }
        asm volatile("s_waitcnt vmcnt(0) lgkmcnt(0)" ::: "memory"); __builtin_amdgcn_s_barrier(); asm volatile("" ::: "memory");
        const bool bad = flag[0] != 0u;
        if (lane < 32) {
            const unsigned long long* slot = (const unsigned long long*)xbuf + (size_t)(u.pm * BM + row) * 4; float mt[4], m2[4]; float ms = 0.f;
#pragma unroll
            for (int t = 0; t < 4; ++t) { if (t < ntn) { const unsigned long long w = __hip_atomic_load(slot + t, __ATOMIC_RELAXED, __HIP_MEMORY_SCOPE_AGENT); mt[t] = __uint_as_float((unsigned)w); m2[t] = __uint_as_float((unsigned)(w >> 32)); } else { mt[t] = 0.f; m2[t] = 0.f; } ms += mt[t]; }
            const float mean = ms / (float)ntn; float q = 0.f;
#pragma unroll
            for (int t = 0; t < 4; ++t) if (t < ntn) { const float dm = mt[t] - mean; q += m2[t] + 256.0f * dm * dm; }
            S[row] = (f32x2v){mean, 1.0f / sqrtf(q / (256.0f * (float)ntn) + eps)};
        }
        asm volatile("s_waitcnt lgkmcnt(0)" ::: "memory"); __builtin_amdgcn_s_barrier(); asm volatile("" ::: "memory");
        return bad;
    }
};
struct EpiLnRes {
    static constexpr bool PERM = false, AFTER_DRAIN = true;
    const float* base; float* out; int ldc; const float* bias; PanelStats st; unsigned poison;
    __device__ __forceinline__ void fused(f32x4 (&acc)[2][2][4][2], const Unit& u, int wr, int wc, int fr, int fq, PG8_LAS unsigned char* lds, int wid, int lane) const {
        typedef float f32x2v __attribute__((ext_vector_type(2)));
        const PG8_LAS f32x2v* S = (const PG8_LAS f32x2v*)(lds + 8192);
        const int col0 = u.pn * BM + wc * 32 + 4 * fq;
#pragma unroll
        for (int bj = 0; bj < 2; ++bj)
#pragma unroll
            for (int n = 0; n < 2; ++n) { const f32x4 bv = bias ? *(const f32x4*)(bias + col0 + bj * HALF + n * 16) : (f32x4){0.f, 0.f, 0.f, 0.f};
#pragma unroll
                for (int ai = 0; ai < 2; ++ai)
#pragma unroll
                    for (int m = 0; m < 4; ++m) acc[ai][bj][m][n] += bv; }
        f32x4 pre[4][2][2];
#pragma unroll
        for (int m = 0; m < 4; ++m) { const size_t off = (size_t)(u.pm * BM + wr * 64 + m * 16 + fr) * ldc + col0;
#pragma unroll
            for (int bj = 0; bj < 2; ++bj)
#pragma unroll
                for (int n = 0; n < 2; ++n) pre[m][bj][n] = *(const f32x4*)(base + off + bj * HALF + n * 16); }
        const bool bad = st.run(acc, u, wr, wc, fr, fq, lds, wid, lane) || poison != 0u;
        const float qnan = __builtin_nanf("");
#pragma unroll
        for (int ai = 0; ai < 2; ++ai)
#pragma unroll
            for (int m = 0; m < 4; ++m) { const int r = ai * HALF + wr * 64 + m * 16 + fr; const f32x2v sr = S[r]; const size_t off = (size_t)(u.pm * BM + r) * ldc + col0;
#pragma unroll
                for (int bj = 0; bj < 2; ++bj)
#pragma unroll
                    for (int n = 0; n < 2; ++n) { const f32x4 bs = ai == 0 ? pre[m][bj][n] : *(const f32x4*)(base + off + bj * HALF + n * 16); f32x4 o = bs + (acc[ai][bj][m][n] - sr.x) * sr.y;
                        if (bad) o = (f32x4){qnan, qnan, qnan, qnan}; *(f32x4*)(out + off + bj * HALF + n * 16) = o; }
                if (m & 1) asm volatile("" ::: "memory"); }
    }
};
struct EpiLnResLn {
    static constexpr bool PERM = false, AFTER_DRAIN = true;
    const float* base; float* out; bf16_t* xn; int ldc; const float* bias; PanelStats st1, st2; unsigned poison;
    __device__ __forceinline__ void fused(f32x4 (&acc)[2][2][4][2], const Unit& u, int wr, int wc, int fr, int fq, PG8_LAS unsigned char* lds, int wid, int lane) const {
        typedef float f32x2v __attribute__((ext_vector_type(2))); typedef unsigned u32x2v __attribute__((ext_vector_type(2)));
        const PG8_LAS f32x2v* S = (const PG8_LAS f32x2v*)(lds + 8192);
        const int col0 = u.pn * BM + wc * 32 + 4 * fq;
#pragma unroll
        for (int bj = 0; bj < 2; ++bj)
#pragma unroll
            for (int n = 0; n < 2; ++n) { const f32x4 bv = bias ? *(const f32x4*)(bias + col0 + bj * HALF + n * 16) : (f32x4){0.f, 0.f, 0.f, 0.f};
#pragma unroll
                for (int ai = 0; ai < 2; ++ai)
#pragma unroll
                    for (int m = 0; m < 4; ++m) acc[ai][bj][m][n] += bv; }
        bool bad = st1.run(acc, u, wr, wc, fr, fq, lds, wid, lane) || poison != 0u;
        const float qnan = __builtin_nanf("");
#pragma unroll
        for (int ai = 0; ai < 2; ++ai)
#pragma unroll
            for (int m = 0; m < 4; ++m) { const int r = ai * HALF + wr * 64 + m * 16 + fr; const f32x2v sr = S[r]; const size_t off = (size_t)(u.pm * BM + r) * ldc + col0;
#pragma unroll
                for (int bj = 0; bj < 2; ++bj)
#pragma unroll
                    for (int n = 0; n < 2; ++n) { const f32x4 bs = *(const f32x4*)(base + off + bj * HALF + n * 16); acc[ai][bj][m][n] = bs + (acc[ai][bj][m][n] - sr.x) * sr.y; }
                asm volatile("" : "+v"(acc[ai][0][m][0]), "+v"(acc[ai][0][m][1]), "+v"(acc[ai][1][m][0]), "+v"(acc[ai][1][m][1]));
                if (m & 1) asm volatile("" ::: "memory"); }
        const bool bad1 = bad;
        bad = st2.run(acc, u, wr, wc, fr, fq, lds, wid, lane) || bad;
#pragma unroll
        for (int ai = 0; ai < 2; ++ai)
#pragma unroll
            for (int m = 0; m < 4; ++m) { const int r = ai * HALF + wr * 64 + m * 16 + fr; const f32x2v sr = S[r]; const size_t off = (size_t)(u.pm * BM + r) * ldc + col0;
#pragma unroll
                for (int bj = 0; bj < 2; ++bj)
#pragma unroll
                    for (int n = 0; n < 2; ++n) { const f32x4 x1 = acc[ai][bj][m][n]; *(f32x4*)(out + off + bj * HALF + n * 16) = bad1 ? (f32x4){qnan, qnan, qnan, qnan} : x1;
                        const f32x4 o = (x1 - sr.x) * sr.y; u32x2v w; w.x = cvt_pk_bf16(o[0], o[1]); w.y = cvt_pk_bf16(o[2], o[3]);
                        if (bad) { w.x = 0x7fc07fc0u; w.y = 0x7fc07fc0u; } *(u32x2v*)(xn + off + bj * HALF + n * 16) = w; }
                asm volatile("" ::: "memory"); }
    }
};

template <class Epi, class Sched, bool ALIGN_EPI = false, bool SP2 = false>
__device__ __forceinline__ void gemm_phase(PG8_LAS unsigned char* lds, const Gemm g, const Sched& S, const Epi& E, const int wid_in  ) {
    int wid_ = wid_in; asm volatile("" : "+s"(wid_)); const int wid = wid_;
    int lane_; asm volatile("v_mbcnt_lo_u32_b32 %0, -1, 0\n\tv_mbcnt_hi_u32_b32 %0, -1, %0" : "=v"(lane_));
    const int lane = lane_, tid = wid * 64 + lane, wr = wid >> 2, wc = wid & 3, fr = lane & 15, fq = lane >> 4;
    const int K = g.K, nt = K / BK;
    unsigned voffA[2], voffB[2];
#pragma unroll
    for (int i = 0; i < 2; ++i) { int R, C; stage_rc(tid * 16 + i * 8192, R, C); const int Rb = Epi::PERM ? ((R & ~31) + perm32(R & 31)) : R;
        voffA[i] = (unsigned)(R * K + C) * 2u; voffB[i] = (unsigned)(Rb * K + C) * 2u; }
    const size_t kstep = (size_t)(BK * 2);
    const size_t hstep = (size_t)HALF * K * 2;
    const size_t tstep = 2 * hstep;
    const unsigned ldsw = (unsigned)wid * 1024u;
    const int aoff = lds_byte(wr * 64 + fr, fq * 8), boff = lds_byte(wc * 32 + fr, fq * 8);
#define PG8_SA(b, h) (((b) * 2 + (h)) * HTB)
#define PG8_SB(b, h) ((4 + (b) * 2 + (h)) * HTB)
#define PG8_STAGE(bufoff, gbase, voff) do { _Pragma("unroll") for (int _i = 0; _i < 2; ++_i) \
        __builtin_amdgcn_global_load_lds((const unsigned*)((const char*)(gbase) + (voff)[_i]), (PG8_LAS unsigned*)(lds + (bufoff) + ldsw + _i * 8192), 16, 0, 0); } while (0)
#define PG8_LDA(dst, b, h) do { _Pragma("unroll") for (int m = 0; m < 4; ++m) _Pragma("unroll") for (int k = 0; k < 2; ++k) dst[m][k] = *(const PG8_LAS bf16x8*)(lds + PG8_SA(b, h) + aoff + m * 2048 + k * 1024); } while (0)
#define PG8_LDB(dst, b, h) do { _Pragma("unroll") for (int n = 0; n < 2; ++n) _Pragma("unroll") for (int k = 0; k < 2; ++k) dst[n][k] = *(const PG8_LAS bf16x8*)(lds + PG8_SB(b, h) + boff + n * 2048 + k * 1024); } while (0)
#define PG8_MMA(ai, bj, At, Bt) do { __builtin_amdgcn_s_setprio(1); _Pragma("unroll") for (int m = 0; m < 4; ++m) _Pragma("unroll") for (int n = 0; n < 2; ++n) _Pragma("unroll") for (int k = 0; k < 2; ++k) \
        acc[ai][bj][m][n] = __builtin_amdgcn_mfma_f32_16x16x32_bf16(Bt[n][k], At[m][k], acc[ai][bj][m][n], 0, 0, 0); __builtin_amdgcn_s_setprio(0); } while (0)
#define PG8_WAIT_V(n) asm volatile("s_waitcnt vmcnt(" #n ")" ::: "memory")
#define PG8_WAIT_L(n) asm volatile("s_waitcnt lgkmcnt(" #n ")" ::: "memory")
#define PG8_BAR __builtin_amdgcn_s_barrier()
#define PG8_SCHED __builtin_amdgcn_sched_barrier(0)
    Unit cur, nxt; int ui = 0;
    if (!S.next(0, cur)) return;
    f32x4 acc[2][2][4][2];
#pragma unroll
    for (int a = 0; a < 2; ++a)
#pragma unroll
        for (int b = 0; b < 2; ++b)
#pragma unroll
            for (int m = 0; m < 4; ++m)
#pragma unroll
                for (int n = 0; n < 2; ++n) acc[a][b][m][n] = (f32x4){0.f, 0.f, 0.f, 0.f};
    bf16x8 At[4][2], B0[2][2], B1[2][2];
    const char* cA = (const char*)g.A + (size_t)cur.pm * tstep; const char* cB = (const char*)g.Bt + (size_t)cur.pn * tstep;
    S.a_ready(cur);
    if constexpr (SP2) {
        PG8_STAGE(PG8_SB(0, 0), cB, voffB); PG8_STAGE(PG8_SB(0, 1), cB + hstep, voffB); PG8_STAGE(PG8_SA(0, 0), cA, voffA); PG8_STAGE(PG8_SA(0, 1), cA + hstep, voffA);
        if (wr == 1) PG8_BAR;
        PG8_WAIT_V(2); PG8_BAR;
        PG8_STAGE(PG8_SB(1, 0), cB + kstep, voffB); PG8_STAGE(PG8_SA(1, 0), cA + kstep, voffA); PG8_STAGE(PG8_SB(1, 1), cB + hstep + kstep, voffB);
        PG8_WAIT_V(6); PG8_BAR;
    } else {
        PG8_STAGE(PG8_SB(0, 0), cB, voffB); PG8_STAGE(PG8_SA(0, 0), cA, voffA); PG8_STAGE(PG8_SB(0, 1), cB + hstep, voffB); PG8_STAGE(PG8_SA(0, 1), cA + hstep, voffA);
        if (wr == 1) PG8_BAR;
        PG8_WAIT_V(4); PG8_BAR;
        PG8_STAGE(PG8_SB(1, 0), cB + kstep, voffB); PG8_STAGE(PG8_SA(1, 0), cA + kstep, voffA); PG8_STAGE(PG8_SB(1, 1), cB + hstep + kstep, voffB);
        PG8_WAIT_V(6); PG8_BAR;
    }
    for (;;) {
        const bool has_next = S.next(ui + 1, nxt);
        const char* nA = has_next ? (const char*)g.A + (size_t)nxt.pm * tstep : cA; const char* nB = has_next ? (const char*)g.Bt + (size_t)nxt.pn * tstep : cB;
        for (int t = 0; t < nt; t += 2) {
            const bool last = (t == nt - 2);
            const char* a1 = cA + (size_t)(t + 1) * kstep;
            const char* a2 = last ? nA : cA + (size_t)(t + 2) * kstep; const char* b2 = last ? nB : cB + (size_t)(t + 2) * kstep;
            const char* a3 = a2 + kstep; const char* b3 = b2 + kstep;
            if (last && has_next) S.a_ready(nxt);
            if constexpr (SP2) {
            PG8_LDB(B0, 0, 0); PG8_LDB(B1, 0, 1); PG8_SCHED; PG8_LDA(At, 0, 0); PG8_STAGE(PG8_SA(1, 1), a1 + hstep, voffA);
            PG8_WAIT_V(8); PG8_WAIT_L(0); PG8_BAR; PG8_MMA(0, 0, At, B0); PG8_MMA(0, 1, At, B1); PG8_BAR; PG8_SCHED;
            PG8_LDA(At, 0, 1); PG8_STAGE(PG8_SB(0, 0), b2, voffB); PG8_STAGE(PG8_SB(0, 1), b2 + hstep, voffB); PG8_STAGE(PG8_SA(0, 0), a2, voffA);
            PG8_WAIT_V(8); PG8_WAIT_L(0); PG8_BAR; PG8_MMA(1, 0, At, B0); PG8_MMA(1, 1, At, B1); PG8_BAR; PG8_SCHED;
            PG8_LDB(B0, 1, 0); PG8_LDB(B1, 1, 1); PG8_SCHED; PG8_LDA(At, 1, 0); PG8_STAGE(PG8_SA(0, 1), a2 + hstep, voffA);
            PG8_WAIT_V(8); PG8_WAIT_L(0); PG8_BAR; PG8_MMA(0, 0, At, B0); PG8_MMA(0, 1, At, B1); PG8_BAR; PG8_SCHED;
            PG8_LDA(At, 1, 1); PG8_STAGE(PG8_SB(1, 0), b3, voffB); PG8_STAGE(PG8_SB(1, 1), b3 + hstep, voffB); PG8_STAGE(PG8_SA(1, 0), a3, voffA);
            PG8_WAIT_V(8); PG8_WAIT_L(0); PG8_BAR; PG8_MMA(1, 0, At, B0); PG8_MMA(1, 1, At, B1); PG8_BAR; PG8_SCHED;
            } else {
            PG8_LDB(B0, 0, 0); PG8_SCHED; PG8_LDA(At, 0, 0); PG8_STAGE(PG8_SA(1, 1), a1 + hstep, voffA);
            PG8_WAIT_L(8); PG8_BAR; PG8_WAIT_L(0); PG8_MMA(0, 0, At, B0); PG8_BAR; PG8_SCHED;
            PG8_LDB(B1, 0, 1); PG8_STAGE(PG8_SB(0, 0), b2, voffB);
            PG8_BAR; PG8_WAIT_L(0); PG8_MMA(0, 1, At, B1); PG8_BAR;
            PG8_LDA(At, 0, 1); PG8_STAGE(PG8_SA(0, 0), a2, voffA);
            PG8_BAR; PG8_WAIT_L(0); PG8_MMA(1, 0, At, B0); PG8_BAR; PG8_SCHED;
            PG8_STAGE(PG8_SB(0, 1), b2 + hstep, voffB);
            PG8_WAIT_V(6); PG8_BAR; PG8_MMA(1, 1, At, B1); PG8_BAR;
            PG8_LDB(B0, 1, 0); PG8_SCHED; PG8_LDA(At, 1, 0); PG8_STAGE(PG8_SA(0, 1), a2 + hstep, voffA);
            PG8_WAIT_L(8); PG8_BAR; PG8_WAIT_L(0); PG8_MMA(0, 0, At, B0); PG8_BAR; PG8_SCHED;
            PG8_LDB(B1, 1, 1); PG8_STAGE(PG8_SB(1, 0), b3, voffB);
            PG8_BAR; PG8_WAIT_L(0); PG8_MMA(0, 1, At, B1); PG8_BAR;
            PG8_LDA(At, 1, 1); PG8_STAGE(PG8_SA(1, 0), a3, voffA);
            PG8_BAR; PG8_WAIT_L(0); PG8_MMA(1, 0, At, B0); PG8_BAR; PG8_SCHED;
            PG8_STAGE(PG8_SB(1, 1), b3 + hstep, voffB);
            PG8_WAIT_V(6); PG8_BAR; PG8_MMA(1, 1, At, B1); PG8_BAR;
            }
        }
        if constexpr (ALIGN_EPI) { if (wr == 0) PG8_BAR; }
        if constexpr (!Epi::AFTER_DRAIN) { E(acc, cur, wr, wc, fr, fq); S.done(cur); }
        if (!has_next) break;
#pragma unroll
        for (int a = 0; a < 2; ++a)
#pragma unroll
            for (int b = 0; b < 2; ++b)
#pragma unroll
                for (int m = 0; m < 4; ++m)
#pragma unroll
                    for (int n = 0; n < 2; ++n) acc[a][b][m][n] = (f32x4){0.f, 0.f, 0.f, 0.f};
        cur = nxt; cA = nA; cB = nB; ++ui;
        if constexpr (ALIGN_EPI) { if (wr == 1) PG8_BAR; }
    }
    PG8_WAIT_V(0);
    if constexpr (!ALIGN_EPI) { if (wr == 0) PG8_BAR; }
    PG8_BAR;
    if constexpr (Epi::AFTER_DRAIN) { E.fused(acc, cur, wr, wc, fr, fq, lds, wid, lane); S.done(cur); }
#undef PG8_SA
#undef PG8_SB
#undef PG8_STAGE
#undef PG8_LDA
#undef PG8_LDB
#undef PG8_MMA
#undef PG8_WAIT_V
#undef PG8_WAIT_L
#undef PG8_BAR
#undef PG8_SCHED
}
}
constexpr int NWAVES = 8;
constexpr int DM = 1024, NB = 8, SEQ = 2048, DEPTH = 4, SBATCH = 8, SSEQ = 16, PAST = 4096;
constexpr int MP = NB * SEQ, MS = SBATCH * SSEQ, MALL = MP + MS, MPAD = 16640;
constexpr int WA = 512, DFF = 2816, PLE = 256, INC = 5128, NPROJ = 5120, NGU = 2 * DFF;
constexpr float LN_EPS = 1e-5f, RMS_EPS = 1e-5f;
constexpr float LOG2E = 1.4426950408889634f;
constexpr float C2 = 0.125f * LOG2E;
constexpr float ALPHA = 1.6817928305074290f;
enum { I_XP = 0, I_XS, I_PP, I_PS, I_CFK, I_CFV, I_CFL, I_CDK, I_CDV, I_WIN, I_BF, I_LQ1, I_LK1, I_LQ2, I_LK2, I_GD, I_WBA, I_WBB, I_WO, I_L1G, I_L1B, I_WG, I_WU, I_WD, I_WPG, I_WPP, I_L2G, I_L2B, N_IN };
constexpr size_t O_YP = 0, O_YS = O_YP + (size_t)MP * DM, O_FKP = O_YS + (size_t)MS * DM, O_FVP = O_FKP + (size_t)DEPTH * MP * 512, O_FLP = O_FVP + (size_t)DEPTH * MP * 512,
                 O_DKP = O_FLP + (size_t)DEPTH * MP * 8, O_DVP = O_DKP + (size_t)DEPTH * MP * 512, O_FKS = O_DVP + (size_t)DEPTH * MP * 512, O_FVS = O_FKS + (size_t)DEPTH * MS * 512,
                 O_FLS = O_FVS + (size_t)DEPTH * MS * 512, O_DKS = O_FLS + (size_t)DEPTH * MS * 8, O_DVS = O_DKS + (size_t)DEPTH * MS * 512, O_END = O_DVS + (size_t)DEPTH * MS * 512;
static_assert(O_END == 152702976ull, "output size");

constexpr size_t MiB = 1u << 20;
constexpr size_t WS_CTL = 0, CTL_ZERO_BYTES = 1 * MiB;
constexpr size_t WL_IN = 0, WL_BA = WL_IN + (size_t)NPROJ * DM * 2, WL_BB = WL_BA + (size_t)DM * 512 * 2, WL_O = WL_BB + (size_t)DM * 512 * 2, WL_GU = WL_O + (size_t)DM * DM * 2,
                 WL_D = WL_GU + (size_t)NGU * DM * 2, WL_PG = WL_D + (size_t)DM * DFF * 2, WL_PPW = WL_PG + (size_t)DM * DM * 2, WL_SIZE = WL_PPW + (size_t)DM * PLE * 2;
constexpr size_t WS_W = 2 * MiB;
constexpr size_t align_up(size_t x) { return (x + 4095) & ~(size_t)4095; }
constexpr size_t WS_XF = align_up(WS_W + DEPTH * WL_SIZE);
constexpr size_t WS_XB = WS_XF + (size_t)MPAD * DM * 4;
constexpr size_t WS_QA = WS_XB + (size_t)MPAD * DM * 2;
constexpr size_t SZ_H = (size_t)MPAD * 512 * 2;
constexpr size_t WS_KA = WS_QA + SZ_H, WS_VA = WS_KA + SZ_H, WS_QB = WS_VA + SZ_H, WS_KB = WS_QB + SZ_H, WS_VB = WS_KB + SZ_H;
constexpr size_t WS_G = WS_VB + SZ_H;
constexpr size_t WS_OA = WS_G + (size_t)MPAD * 2048 * 2;
constexpr size_t WS_OB = WS_OA + SZ_H;
constexpr size_t WS_O12 = WS_OB + SZ_H;
constexpr size_t WS_T1 = WS_O12 + (size_t)MPAD * DM * 4;
constexpr size_t WS_MG = WS_T1 + (size_t)MPAD * DM * 4;
constexpr size_t WS_PRE = WS_MG + (size_t)MPAD * DM * 2;
constexpr size_t WS_HB = WS_PRE + (size_t)MPAD * DM * 4;
constexpr size_t WS_PPO = WS_HB + (size_t)MPAD * DFF * 2;
constexpr size_t WS_PLE = WS_PPO + (size_t)MPAD * DM * 4;
constexpr size_t WS_PB = WS_PLE + (size_t)MPAD * DM * 4;
constexpr size_t WS_LF = WS_PB + (size_t)DEPTH * MPAD * PLE * 2;
constexpr size_t WS_CKP = WS_LF + (size_t)MPAD * 8 * 4;
constexpr size_t WS_CKS = WS_CKP + (size_t)64 * SEQ * 4;
constexpr size_t WS_CP = WS_CKS + 4096;
constexpr size_t WS_END = WS_CP + (size_t)DEPTH * 64 * PAST * 4;
constexpr int CW_TMO = 0, CW_CODE = 1, CW_BAR = 4096;
#define GAS __attribute__((address_space(1)))
#define LAS __attribute__((address_space(3)))
typedef unsigned short bf16;
typedef unsigned v4u __attribute__((ext_vector_type(4)));
typedef float f32x4 __attribute__((ext_vector_type(4)));
typedef short bf16x8 __attribute__((ext_vector_type(8)));
typedef GAS unsigned gu32;
typedef GAS unsigned long long gu64;
#define RLX_AGENT __ATOMIC_RELAXED, __HIP_MEMORY_SCOPE_AGENT
#define LDS_WAIT() asm volatile("s_waitcnt lgkmcnt(0)" ::: "memory")
#define VM_WAIT() asm volatile("s_waitcnt vmcnt(0)" ::: "memory")
__device__ __forceinline__ unsigned long long rt() { return __builtin_amdgcn_s_memrealtime(); }
__device__ __forceinline__ unsigned f2bf(float f) { unsigned u = __builtin_bit_cast(unsigned, f); return (u + 0x7fffu + ((u >> 16) & 1u)) >> 16; }
__device__ __forceinline__ unsigned pk2(float lo, float hi) { return f2bf(lo) | (f2bf(hi) << 16); }

#define XB_TMO      128
#define XB_XCNT(j)  (256  + 64 * (j))
#define XB_XSUB(j)  (1280 + 64 * (j))
#define XB_XGEN(j)  (2304 + 64 * (j))
#define XB_TOP      3328
#define XB_TOPGEN   3392
#define XCD_BAR_WORDS 3456
#define XB_SPIN_CAP (1u << 18)

__device__ __forceinline__ unsigned xb_ld(unsigned* p)              { return __hip_atomic_load(p, __ATOMIC_RELAXED, __HIP_MEMORY_SCOPE_AGENT); }
__device__ __forceinline__ unsigned xb_add(unsigned* p, unsigned v) { return __hip_atomic_fetch_add(p, v, __ATOMIC_RELAXED, __HIP_MEMORY_SCOPE_AGENT); }
__device__ __forceinline__ unsigned xb_xcc_id() { return (unsigned)__builtin_amdgcn_s_getreg((3 << 11) | 20) & 0xFu; }
#define XB_SPIN(cond, bar) do { unsigned _sp = 0; while (cond) { __builtin_amdgcn_s_sleep(1); \
    if ((++_sp & 255u) == 0u) { if (xb_ld(&(bar)[XB_TMO])) break; if (_sp > XB_SPIN_CAP) { atomicAdd(&(bar)[XB_TMO], 1u); break; } } } } while (0)

struct XcdBarrier {
    unsigned* bar; unsigned x;
    volatile LAS unsigned* st;
};

__device__ __forceinline__ XcdBarrier xcd_barrier_post(unsigned* bar, volatile LAS unsigned* st) {
    XcdBarrier b; b.bar = bar; b.x = xb_xcc_id(); b.st = st;
    if (threadIdx.x == 0) (void)xb_add(&bar[XB_XCNT(b.x)], 1u);
    return b;
}
__device__ __forceinline__ void xcd_barrier_complete(unsigned* bar, unsigned x, unsigned& nloc, unsigned& nx) {
    const unsigned G = gridDim.x * gridDim.y * gridDim.z;
    unsigned sum, cnt, mine, sp = 0u;
    for (;;) {
        sum = 0u; cnt = 0u; mine = 0u;
#pragma unroll
        for (unsigned j = 0; j < 16; ++j) { const unsigned c = xb_ld(&bar[XB_XCNT(j)]); sum += c; cnt += (c > 0u) ? 1u : 0u; mine = (j == x) ? c : mine; }
        if (sum == G) break;
        __builtin_amdgcn_s_sleep(1);
        if ((++sp & 255u) == 0u) { if (xb_ld(&bar[XB_TMO])) break; if (sp > XB_SPIN_CAP) { atomicAdd(&bar[XB_TMO], 1u); break; } }
    }
    nloc = mine > 0u ? mine : 1u; nx = cnt > 0u ? cnt : 1u;
}

__device__ __forceinline__ void xcd_barrier(const XcdBarrier& b) {
    asm volatile("s_waitcnt vmcnt(0)" ::: "memory");
    __syncthreads();
    if (threadIdx.x == 0) {
        unsigned* bar = b.bar;
        __builtin_amdgcn_s_waitcnt(0);
        unsigned nloc = b.st[0], nx = b.st[1];
        if (nloc == 0u) { xcd_barrier_complete(bar, b.x, nloc, nx); b.st[0] = nloc; b.st[1] = nx; }
        const unsigned old = xb_add(&bar[XB_XSUB(b.x)], 1u);
        const unsigned gen = old / nloc;
        if (old + 1u == (gen + 1u) * nloc) {
            __builtin_amdgcn_fence(__ATOMIC_RELEASE, "agent");
            asm volatile("s_waitcnt vmcnt(0)" ::: "memory");
            const unsigned og = xb_add(&bar[XB_TOP], 1u);
            const unsigned tg = og / nx;
            if (og + 1u == (tg + 1u) * nx) xb_add(&bar[XB_TOPGEN], 1u);
            else XB_SPIN(xb_ld(&bar[XB_TOPGEN]) == tg, bar);
            __builtin_amdgcn_fence(__ATOMIC_ACQUIRE, "agent");
            xb_add(&bar[XB_XGEN(b.x)], 1u);
            asm volatile("s_waitcnt vmcnt(0)" ::: "memory");
        } else {
            XB_SPIN(xb_ld(&bar[XB_XGEN(b.x)]) == gen, bar);
            __builtin_amdgcn_fence(__ATOMIC_ACQUIRE, "agent");
            asm volatile("s_waitcnt vmcnt(0)" ::: "memory");
        }
    }
    __syncthreads();
}
namespace epi {
using pg8::f32x4; using pg8::Unit; using pg8::BM; using pg8::HALF; using pg8::bf16_t; using pg8::u32x4; using pg8::cvt_pk_bf16;
__device__ __forceinline__ float bf2f(unsigned short b) { return __uint_as_float((unsigned)b << 16); }
__device__ __forceinline__ float sigm(float v) { return 1.0f / (1.0f + __expf(-v)); }
__device__ __forceinline__ u32x4 pack8(const f32x4& a, const f32x4& b) { u32x4 w; w.x = cvt_pk_bf16(a[0], a[1]); w.y = cvt_pk_bf16(a[2], a[3]); w.z = cvt_pk_bf16(b[0], b[1]); w.w = cvt_pk_bf16(b[2], b[3]); return w; }
__device__ __forceinline__ void unpack8(const u32x4& w, f32x4& a, f32x4& b) {
    a[0] = __uint_as_float(w.x << 16); a[1] = __uint_as_float(w.x & 0xffff0000u); a[2] = __uint_as_float(w.y << 16); a[3] = __uint_as_float(w.y & 0xffff0000u);
    b[0] = __uint_as_float(w.z << 16); b[1] = __uint_as_float(w.z & 0xffff0000u); b[2] = __uint_as_float(w.w << 16); b[3] = __uint_as_float(w.w & 0xffff0000u); }
template <class F> struct EpiRow8 {
    static constexpr bool PERM = true, AFTER_DRAIN = false; F f;
    __device__ __forceinline__ void operator()(const f32x4 (&acc)[2][2][4][2], const Unit& u, int wr, int wc, int fr, int fq) const {
        const int row0 = u.pm * BM + wr * 64 + fr, col0 = u.pn * BM + wc * 32 + 8 * fq;
#pragma unroll
        for (int ai = 0; ai < 2; ++ai)
#pragma unroll
            for (int m = 0; m < 4; ++m)
#pragma unroll
                for (int bj = 0; bj < 2; ++bj) f(row0 + ai * HALF + m * 16, col0 + bj * HALF, acc[ai][bj][m][0], acc[ai][bj][m][1]);
    }
};
struct EpiSwiGLU {
    static constexpr bool PERM = true, AFTER_DRAIN = false; bf16_t* H; int ldh;
    __device__ __forceinline__ void operator()(const f32x4 (&acc)[2][2][4][2], const Unit& u, int wr, int wc, int fr, int fq) const {
        const int row0 = u.pm * BM + wr * 64 + fr, col0 = u.pn * HALF + wc * 32 + 8 * fq;
#pragma unroll
        for (int ai = 0; ai < 2; ++ai)
#pragma unroll
            for (int m = 0; m < 4; ++m) { f32x4 o0, o1;
#pragma unroll
                for (int e = 0; e < 4; ++e) { const float g0 = acc[ai][0][m][0][e], g1 = acc[ai][0][m][1][e]; o0[e] = g0 * sigm(g0) * acc[ai][1][m][0][e]; o1[e] = g1 * sigm(g1) * acc[ai][1][m][1][e]; }
                *(u32x4*)(H + (size_t)(row0 + ai * HALF + m * 16) * ldh + col0) = pack8(o0, o1); }
    }
};
struct FProj {
    unsigned char* ws; float* out; int l;
    __device__ __forceinline__ void operator()(int row, int col, f32x4 v0, f32x4 v1) const {
        const int pn = col >> 8;
        if (pn < 12) { const int kind = pn >> 1, cw = col - kind * 512;
            if (kind == 0 || kind == 3) { v0 = v0 * C2; v1 = v1 * C2; }
            else if (row < MALL) {
                const size_t oP = kind == 1 ? O_FKP : (kind == 2 ? O_FVP : (kind == 4 ? O_DKP : O_DVP)), oS = kind == 1 ? O_FKS : (kind == 2 ? O_FVS : (kind == 4 ? O_DKS : O_DVS));
                float* o = (row < MP) ? out + oP + ((size_t)l * MP + row) * 512 + cw : out + oS + ((size_t)l * MS + (row - MP)) * 512 + cw; *(f32x4*)o = v0; *(f32x4*)(o + 4) = v1; }
            *(u32x4*)((bf16_t*)(ws + WS_QA + (size_t)kind * SZ_H) + (size_t)row * 512 + cw) = pack8(v0, v1);
        } else { f32x4 s0, s1;
#pragma unroll
            for (int e = 0; e < 4; ++e) { s0[e] = sigm(v0[e]); s1[e] = sigm(v1[e]); }
            *(u32x4*)((bf16_t*)(ws + WS_G) + (size_t)row * 2048 + (col - 3072)) = pack8(s0, s1); }
    }
};
struct FGate1 { const bf16_t* G; float* T1;
    __device__ __forceinline__ void operator()(int row, int col, f32x4 v0, f32x4 v1) const { f32x4 g0, g1; unpack8(*(const u32x4*)(G + (size_t)row * 2048 + col), g0, g1);
        float* o = T1 + (size_t)row * DM + col; *(f32x4*)o = g0 * v0; *(f32x4*)(o + 4) = g1 * v1; } };
struct FGate2 { const bf16_t* G; const float* T1; bf16_t* MGo;
    __device__ __forceinline__ void operator()(int row, int col, f32x4 v0, f32x4 v1) const { f32x4 g0, g1; unpack8(*(const u32x4*)(G + (size_t)row * 2048 + 1024 + col), g0, g1);
        const float* t = T1 + (size_t)row * DM + col; const f32x4 a = *(const f32x4*)t + g0 * v0, b = *(const f32x4*)(t + 4) + g1 * v1;
        *(u32x4*)(MGo + (size_t)row * DM + col) = pack8(a, b); } };
struct FRes { const float* X; const float* Add; float* PRE;
    __device__ __forceinline__ void operator()(int row, int col, f32x4 v0, f32x4 v1) const { const size_t off = (size_t)row * DM + col;
        f32x4 a = *(const f32x4*)(X + off) * ALPHA + v0, b = *(const f32x4*)(X + off + 4) * ALPHA + v1;
        if (Add) { a = a + *(const f32x4*)(Add + off); b = b + *(const f32x4*)(Add + off + 4); }
        *(f32x4*)(PRE + off) = a; *(f32x4*)(PRE + off + 4) = b; } };
struct FStoreF32 { float* O;
    __device__ __forceinline__ void operator()(int row, int col, f32x4 v0, f32x4 v1) const { float* o = O + (size_t)row * DM + col; *(f32x4*)o = v0; *(f32x4*)(o + 4) = v1; } };
struct FPleGate { const float* PPo; float* PLEo;
    __device__ __forceinline__ void operator()(int row, int col, f32x4 v0, f32x4 v1) const { const size_t off = (size_t)row * DM + col; f32x4 a = *(const f32x4*)(PPo + off), b = *(const f32x4*)(PPo + off + 4);
#pragma unroll
        for (int e = 0; e < 4; ++e) { a[e] *= sigm(v0[e]); b[e] *= sigm(v1[e]); }
        *(f32x4*)(PLEo + off) = a; *(f32x4*)(PLEo + off + 4) = b; } };
}
constexpr int RING_OFF = 0, RING_BYTES = 131072;
constexpr int LDSCTL_OFF = RING_BYTES, MISC_OFF = LDSCTL_OFF + 320;
constexpr int LDS_BYTES = 147456;
struct Args { const float* in[N_IN]; float* out; unsigned char* ws; int ph_lo, ph_hi; };
#define GIN(A, i) ((const float*)(const GAS float*)(A)->in[i])
#define GOUT(A) ((float*)(GAS float*)(A)->out)
#define GWS(A) ((unsigned char*)(GAS unsigned char*)(A)->ws)
static_assert(sizeof(Args) == (N_IN + 2) * 8 + 8, "Args has no padding");
struct Frame {
    LAS unsigned char* lds; volatile LAS unsigned* MISC; gu32* ctl;
    int tid, lane, wave, vcu, G;
};
__device__ __forceinline__ float lane_get(float v, int src_lane) { return __int_as_float(__builtin_amdgcn_ds_bpermute(src_lane << 2, __float_as_int(v))); }
__device__ __forceinline__ float wave_sum(float v, int lane) {
#pragma unroll
    for (int o = 1; o < 64; o <<= 1) v += lane_get(v, lane ^ o);
    return v;
}
__device__ __forceinline__ void transpose_tile(const float* src, int ldw, bf16* dst, int ldt, LAS float* scr, int lane) {
#pragma unroll 8
    for (int i = 0; i < 32; ++i) { const int kk = 2 * i + (lane >> 5); scr[kk * 33 + (lane & 31)] = src[(size_t)kk * ldw + (lane & 31)]; }
    LDS_WAIT(); asm volatile("" ::: "memory");
    const int c = lane & 7;
#pragma unroll
    for (int j = 0; j < 4; ++j) { const int n = (lane >> 3) + 8 * j; const LAS float* s = scr + (8 * c) * 33 + n;
        v4u o; o.x = pk2(s[0 * 33], s[1 * 33]); o.y = pk2(s[2 * 33], s[3 * 33]); o.z = pk2(s[4 * 33], s[5 * 33]); o.w = pk2(s[6 * 33], s[7 * 33]);
        *(GAS v4u*)(dst + (size_t)n * ldt + 8 * c) = o; }
    LDS_WAIT(); asm volatile("" ::: "memory");
}
__device__ __forceinline__ float lambda_init_of(int l) { return 0.8f - 0.6f * __expf(-0.3f * (float)l); }

template <class AP> __device__ __forceinline__ void p0_prologue(Frame& F, const AP A) {
    unsigned char* ws = GWS(A);
    LAS float* scr = (LAS float*)(F.lds + RING_OFF + F.wave * 16384);
    const int gw = F.vcu * NWAVES + F.wave, NGW = F.G * NWAVES;
    constexpr int I_IN = 16 * (NPROJ / 32), I_BA = 8 * 32, I_O = 16 * 32, I_G = 16 * (DFF / 32), I_D = (DFF / 64) * 32, I_PPW = 4 * 32;
    constexpr int PER_L = I_IN + 2 * I_BA + I_O + 2 * I_G + I_D + I_O + I_PPW;
    for (int it = gw; it < DEPTH * PER_L; it += NGW) {
        const int l = it / PER_L; int r = it % PER_L; unsigned char* wl = ws + WS_W + (size_t)l * WL_SIZE;
        if (r < I_IN) { const int nblk = NPROJ / 32, kb = r / nblk, nb = r % nblk, n0 = 32 * nb, sc = n0 < 1536 ? n0 : n0 + 8;
            transpose_tile(GIN(A, I_WIN) + (size_t)l * DM * INC + (size_t)(64 * kb) * INC + sc, INC, (bf16*)(wl + WL_IN) + (size_t)n0 * DM + 64 * kb, DM, scr, F.lane); continue; } r -= I_IN;
        if (r < I_BA) { const int kb = r / 32, nb = r % 32; transpose_tile(GIN(A, I_WBA) + (size_t)l * 512 * DM + (size_t)(64 * kb) * DM + 32 * nb, DM, (bf16*)(wl + WL_BA) + (size_t)(32 * nb) * 512 + 64 * kb, 512, scr, F.lane); continue; } r -= I_BA;
        if (r < I_BA) { const int kb = r / 32, nb = r % 32; transpose_tile(GIN(A, I_WBB) + (size_t)l * 512 * DM + (size_t)(64 * kb) * DM + 32 * nb, DM, (bf16*)(wl + WL_BB) + (size_t)(32 * nb) * 512 + 64 * kb, 512, scr, F.lane); continue; } r -= I_BA;
        if (r < I_O) { const int kb = r / 32, nb = r % 32; transpose_tile(GIN(A, I_WO) + (size_t)l * DM * DM + (size_t)(64 * kb) * DM + 32 * nb, DM, (bf16*)(wl + WL_O) + (size_t)(32 * nb) * DM + 64 * kb, DM, scr, F.lane); continue; } r -= I_O;
        if (r < 2 * I_G) { const int which = r / I_G; r %= I_G; const int nblk = DFF / 32, kb = r / nblk, nb = r % nblk, n0 = 32 * nb, dr = (n0 / 128) * 256 + (n0 % 128) + which * 128;
            transpose_tile((which ? GIN(A, I_WU) : GIN(A, I_WG)) + (size_t)l * DM * DFF + (size_t)(64 * kb) * DFF + n0, DFF, (bf16*)(wl + WL_GU) + (size_t)dr * DM + 64 * kb, DM, scr, F.lane); continue; } r -= 2 * I_G;
        if (r < I_D) { const int kb = r / 32, nb = r % 32; transpose_tile(GIN(A, I_WD) + (size_t)l * DFF * DM + (size_t)(64 * kb) * DM + 32 * nb, DM, (bf16*)(wl + WL_D) + (size_t)(32 * nb) * DFF + 64 * kb, DFF, scr, F.lane); continue; } r -= I_D;
        if (r < I_O) { const int kb = r / 32, nb = r % 32; transpose_tile(GIN(A, I_WPG) + (size_t)l * DM * DM + (size_t)(64 * kb) * DM + 32 * nb, DM, (bf16*)(wl + WL_PG) + (size_t)(32 * nb) * DM + 64 * kb, DM, scr, F.lane); continue; } r -= I_O;
        { const int kb = r / 32, nb = r % 32; transpose_tile(GIN(A, I_WPP) + (size_t)l * PLE * DM + (size_t)(64 * kb) * DM + 32 * nb, DM, (bf16*)(wl + WL_PPW) + (size_t)(32 * nb) * PLE + 64 * kb, PLE, scr, F.lane); }
    }
    float* XF = (float*)(ws + WS_XF); bf16* XB = (bf16*)(ws + WS_XB);
    for (int m = gw; m < MPAD; m += NGW) {
        const float* src = m < MP ? GIN(A, I_XP) + (size_t)m * DM : (m < MALL ? GIN(A, I_XS) + (size_t)(m - MP) * DM : nullptr);
#pragma unroll
        for (int j = 0; j < 4; ++j) { f32x4 v = src ? *((const GAS f32x4*)src + F.lane + 64 * j) : (f32x4){0.f, 0.f, 0.f, 0.f};
            *((GAS f32x4*)(XF + (size_t)m * DM) + F.lane + 64 * j) = v;
            *((GAS unsigned long long*)(XB + (size_t)m * DM) + F.lane + 64 * j) = (unsigned long long)pk2(v.x, v.y) | ((unsigned long long)pk2(v.z, v.w) << 32); }
    }
    bf16* PB = (bf16*)(ws + WS_PB);
    for (int it = gw; it < DEPTH * MPAD; it += NGW) { const int l = it / MPAD, m = it % MPAD;
        const float* src = m < MP ? GIN(A, I_PP) + ((size_t)l * MP + m) * PLE : (m < MALL ? GIN(A, I_PS) + ((size_t)l * MS + (m - MP)) * PLE : nullptr);
        f32x4 v = src ? *((const GAS f32x4*)src + F.lane) : (f32x4){0.f, 0.f, 0.f, 0.f};
        *((GAS unsigned long long*)(PB + (size_t)it * PLE) + F.lane) = (unsigned long long)pk2(v.x, v.y) | ((unsigned long long)pk2(v.z, v.w) << 32); }
    float* CP = (float*)(ws + WS_CP);
    for (int s = gw; s < DEPTH * 64; s += NGW) { const int lb = s >> 3, h = s & 7; const float* src = GIN(A, I_CFL) + (size_t)lb * PAST * 8 + h;
        float v[64]; float run = 0.f;
#pragma unroll
        for (int j = 0; j < 64; ++j) { run += src[(size_t)(F.lane * 64 + j) * 8]; v[j] = run; }
        float tot = run, incl = tot;
#pragma unroll
        for (int o = 1; o < 64; o <<= 1) { const float t = lane_get(incl, (F.lane - o) & 63); if (F.lane >= o) incl += t; }
        const float excl = incl - tot;
#pragma unroll
        for (int j = 0; j < 64; ++j) CP[(size_t)s * PAST + F.lane * 64 + j] = v[j] + excl;
    }
}
template <class AP> __device__ __forceinline__ void logf_phase(Frame& F, const AP A, int l) {
    unsigned char* ws = GWS(A); const float* XF = (const float*)(ws + WS_XF); float* LF = (float*)(ws + WS_LF);
    LAS float* wf = (LAS float*)(F.lds + RING_OFF);
    const float* win = GIN(A, I_WIN) + (size_t)l * DM * INC + 1536;
    for (int e = F.tid; e < 8 * DM; e += NWAVES * 64) { const int k = e >> 3, h = e & 7; wf[h * DM + k] = win[(size_t)k * INC + h]; }
    __syncthreads();
    const int gw = F.vcu * NWAVES + F.wave, NGW = F.G * NWAVES;
    const float bfv = GIN(A, I_BF)[l * 8 + (F.lane & 7)];
    for (int m = gw; m < MALL; m += NGW) {
        f32x4 x[4];
#pragma unroll
        for (int j = 0; j < 4; ++j) x[j] = *((const GAS f32x4*)(XF + (size_t)m * DM) + F.lane + 64 * j);
        float z = 0.f;
#pragma unroll
        for (int h = 0; h < 8; ++h) { float s = 0.f;
#pragma unroll
            for (int j = 0; j < 4; ++j) { const f32x4 w = *((const LAS f32x4*)(wf + h * DM) + F.lane + 64 * j); s += (x[j].x * w.x + x[j].y * w.y) + (x[j].z * w.z + x[j].w * w.w); }
            s = wave_sum(s, F.lane); if ((F.lane & 7) == h) z = s; }
        z += bfv;
        const float lf = fminf(z, 0.f) - log1pf(__expf(-fabsf(z)));
        if (F.lane < 8) { LF[(size_t)m * 8 + F.lane] = lf;
            if (m < MP) GOUT(A)[O_FLP + ((size_t)l * MP + m) * 8 + F.lane] = lf; else GOUT(A)[O_FLS + ((size_t)l * MS + (m - MP)) * 8 + F.lane] = lf; }
    }
    __syncthreads();
}
template <class AP> __device__ __forceinline__ void scan_phase(Frame& F, const AP A, int l) {
    unsigned char* ws = GWS(A); const float* LF = (const float*)(ws + WS_LF); float* CKP = (float*)(ws + WS_CKP); float* CKS = (float*)(ws + WS_CKS); const float* CP = (const float*)(ws + WS_CP);
    const int gw = F.vcu * NWAVES + F.wave, NGW = F.G * NWAVES;
    for (int s = gw; s < 128; s += NGW) {
        if (s < 64) { const int b = s >> 3, h = s & 7; float v[32]; float run = 0.f;
#pragma unroll
            for (int j = 0; j < 32; ++j) { run += LF[((size_t)b * SEQ + F.lane * 32 + j) * 8 + h]; v[j] = run; }
            float tot = run, incl = tot;
#pragma unroll
            for (int o = 1; o < 64; o <<= 1) { const float t = lane_get(incl, (F.lane - o) & 63); if (F.lane >= o) incl += t; }
            const float excl = incl - tot;
#pragma unroll
            for (int j = 0; j < 32; ++j) CKP[(size_t)s * SEQ + F.lane * 32 + j] = -(v[j] + excl) * LOG2E;
        } else { const int bh = s - 64, b = bh >> 3, h = bh & 7;
            float x = F.lane < SSEQ ? LF[((size_t)MP + b * SSEQ + F.lane) * 8 + h] : 0.f, incl = x;
#pragma unroll
            for (int o = 1; o < 16; o <<= 1) { const float t = lane_get(incl, (F.lane - o) & 63); if (F.lane >= o) incl += t; }
            const float base = CP[((size_t)(l * 8 + b) * 8 + h) * PAST + PAST - 1];
            if (F.lane < SSEQ) CKS[bh * SSEQ + F.lane] = -(base + incl) * LOG2E; }
    }
}
template <class AP> __device__ __forceinline__ void diff_finalize(Frame& F, const AP A, int l) {
    unsigned char* ws = GWS(A); const float* O12 = (const float*)(ws + WS_O12); bf16* OB = (bf16*)(ws + WS_OB);
    const int gw = F.vcu * NWAVES + F.wave, NGW = F.G * NWAVES;
    const float li = lambda_init_of(l);
    const float d1 = wave_sum(GIN(A, I_LQ1)[l * 64 + F.lane] * GIN(A, I_LK1)[l * 64 + F.lane], F.lane), d2 = wave_sum(GIN(A, I_LQ2)[l * 64 + F.lane] * GIN(A, I_LK2)[l * 64 + F.lane], F.lane);
    const float lam = __expf(d1) - __expf(d2) + li;
    const int h = F.lane >> 4, e0 = (F.lane & 15) * 8;
    f32x4 g0 = *(const GAS f32x4*)(GIN(A, I_GD) + l * 512 + h * 128 + e0), g1 = *(const GAS f32x4*)(GIN(A, I_GD) + l * 512 + h * 128 + e0 + 4);
    g0 = g0 * (1.0f - li); g1 = g1 * (1.0f - li);
    for (int m = gw; m < MP; m += NGW) {
        const float* o1 = O12 + (size_t)m * DM + (2 * h) * 128 + e0; const float* o2 = o1 + 128;
        f32x4 a0 = *(const GAS f32x4*)o1 - *(const GAS f32x4*)o2 * lam, a1 = *(const GAS f32x4*)(o1 + 4) - *(const GAS f32x4*)(o2 + 4) * lam;
        float ss = (a0.x * a0.x + a0.y * a0.y) + (a0.z * a0.z + a0.w * a0.w) + (a1.x * a1.x + a1.y * a1.y) + (a1.z * a1.z + a1.w * a1.w);
        ss += lane_get(ss, F.lane ^ 1); ss += lane_get(ss, F.lane ^ 2); ss += lane_get(ss, F.lane ^ 4); ss += lane_get(ss, F.lane ^ 8);
        const float r = 1.0f / sqrtf(ss * (1.0f / 128.0f) + RMS_EPS);
        a0 = a0 * r * g0; a1 = a1 * r * g1;
        v4u o; o.x = pk2(a0.x, a0.y); o.y = pk2(a0.z, a0.w); o.z = pk2(a1.x, a1.y); o.w = pk2(a1.z, a1.w);
        *(GAS v4u*)(OB + (size_t)m * 512 + h * 128 + e0) = o;
    }
}
template <class AP> __device__ __forceinline__ void ln_phase(Frame& F, const AP A, const float* g, const float* b, bool write_y) {
    unsigned char* ws = GWS(A); const float* PRE = (const float*)(ws + WS_PRE); float* XF = (float*)(ws + WS_XF); bf16* XB = (bf16*)(ws + WS_XB);
    const int gw = F.vcu * NWAVES + F.wave, NGW = F.G * NWAVES;
    f32x4 gv[4], bv[4];
#pragma unroll
    for (int j = 0; j < 4; ++j) { gv[j] = *((const GAS f32x4*)g + F.lane + 64 * j); bv[j] = *((const GAS f32x4*)b + F.lane + 64 * j); }
    for (int m = gw; m < MALL; m += NGW) {
        f32x4 v[4]; float s = 0.f;
#pragma unroll
        for (int j = 0; j < 4; ++j) { v[j] = *((const GAS f32x4*)(PRE + (size_t)m * DM) + F.lane + 64 * j); s += (v[j].x + v[j].y) + (v[j].z + v[j].w); }
        const float mean = wave_sum(s, F.lane) * (1.f / DM); float s2 = 0.f;
#pragma unroll
        for (int j = 0; j < 4; ++j) { v[j] = v[j] - mean; s2 += (v[j].x * v[j].x + v[j].y * v[j].y) + (v[j].z * v[j].z + v[j].w * v[j].w); }
        const float rstd = 1.f / sqrtf(wave_sum(s2, F.lane) * (1.f / DM) + LN_EPS);
        float* y = write_y ? (m < MP ? GOUT(A) + O_YP + (size_t)m * DM : GOUT(A) + O_YS + (size_t)(m - MP) * DM) : nullptr;
#pragma unroll
        for (int j = 0; j < 4; ++j) { const f32x4 o = v[j] * rstd * gv[j] + bv[j];
            *((GAS f32x4*)(XF + (size_t)m * DM) + F.lane + 64 * j) = o;
            *((GAS unsigned long long*)(XB + (size_t)m * DM) + F.lane + 64 * j) = (unsigned long long)pk2(o.x, o.y) | ((unsigned long long)pk2(o.z, o.w) << 32);
            if (y) *((GAS f32x4*)y + F.lane + 64 * j) = o; }
    }
}
namespace attn_body {
using bf16=__hip_bfloat16;
using bf16x8=__attribute__((ext_vector_type(8)))short;
using s16x4=__attribute__((ext_vector_type(4)))short;
using f32x16=__attribute__((ext_vector_type(16)))float;
using u32x4=__attribute__((ext_vector_type(4)))unsigned;
typedef float f32x4_t __attribute__((ext_vector_type(4)));
constexpr int BATCH=8,SEQ=2048,D=64,DM=512;
constexpr int NW=8,QBLK=32,QB=QBLK*NW,KVBLK=64,NQB=SEQ/QB;
constexpr int ATTN_PITCH=DM, ATTN_UNIT_ROWS=QB;
__device__ __forceinline__ int crow(int r,int hi){return (r&3)+8*(r>>2)+4*hi;}
#define SBAR() __builtin_amdgcn_sched_barrier(0)
__device__ __forceinline__ void cmask(f32x16&p0,f32x16&p1,int jb,int qrel,int hi){
  const float NEG=-INFINITY; int kb=64*jb+4*hi;
  #pragma unroll
  for(int r=0;r<16;++r){int kv=kb+(r&3)+8*(r>>2); if(kv>qrel)p0[r]=NEG; if(kv+32>qrel)p1[r]=NEG;}
}

__device__ __forceinline__ void cmask_diff(f32x16&p0,f32x16&p1,int jb,int qrel,int hi,int cw,float s2x2){
  if(jb>cw){ const float NEG=-INFINITY;
    #pragma unroll
    for(int r=0;r<16;++r){p0[r]=NEG;p1[r]=NEG;} }
  else if(jb==cw){ int kb=64*jb+4*hi-qrel; asm volatile("":"+v"(kb));
    #pragma unroll
    for(int r=0;r<16;++r){const int dk=kb+(r&3)+8*(r>>2); p0[r]-=s2x2*(float)max(dk,0); p1[r]-=s2x2*(float)max(dk+32,0);} }
}
constexpr int NSLOT=3, SLOTB=8192;
constexpr int LDS_K=0, LDS_V=NSLOT*SLOTB, LDS_WS=2*NSLOT*SLOTB, LDS_OST=LDS_WS+NW*64*4, LDS_TBL=LDS_OST+NW*4096, LDS_BYTES=LDS_TBL+SEQ*4;
constexpr float C2=0.125f*1.4426950408889634f;
__device__ __forceinline__ void glds16(const void*gbase,unsigned voff,unsigned lds_dst){unsigned keep;
  asm volatile("s_mov_b32 %0, m0\n\ts_mov_b32 m0, %3\n\ts_nop 0\n\tglobal_load_lds_dwordx4 %1, %2\n\ts_mov_b32 m0, %0":"=&s"(keep):"v"(voff),"s"(gbase),"s"(lds_dst):"memory");}
__device__ __forceinline__ float max3f(float a,float b,float c){float r;asm("v_max3_f32 %0, %1, %2, %3":"=v"(r):"v"(a),"v"(b),"v"(c));return r;}
__device__ __forceinline__ float max2f(float a,float b){float r;asm("v_max_f32_e32 %0, %1, %2":"=v"(r):"v"(a),"v"(b));return r;}
__device__ __forceinline__ float fadd_s(float a,float b){float r;asm("v_add_f32_e32 %0, %1, %2":"=v"(r):"v"(a),"v"(b));return r;}
__device__ __forceinline__ float fsub_s(float a,float b){float r;asm("v_sub_f32_e32 %0, %1, %2":"=v"(r):"v"(a),"v"(b));return r;}
typedef float f32x2_t __attribute__((ext_vector_type(2))); typedef __bf16 bf16x2_t __attribute__((ext_vector_type(2)));
__device__ __forceinline__ unsigned cvtpk_s(float lo,float hi){f32x2_t v={lo,hi};bf16x2_t b=__builtin_convertvector(v,bf16x2_t);return __builtin_bit_cast(unsigned,b);}
#define WAIT_BAR(N) asm volatile("s_waitcnt vmcnt(" #N ") lgkmcnt(0)\n\ts_barrier":::"memory")

__device__ __forceinline__ void qkt(f32x16&p0,f32x16&p1,const char*Kslot,const bf16x8*qr,const f32x16&negm,int r32,int hi){
  const char*kb=Kslot+hi*1024+r32*16;
  #pragma unroll
  for(int d0=0;d0<4;++d0){
    const bf16x8 b0=*reinterpret_cast<const bf16x8*>(kb+d0*2048);
    const bf16x8 b1=*reinterpret_cast<const bf16x8*>(kb+d0*2048+512);
    if(d0==0){p0=__builtin_amdgcn_mfma_f32_32x32x16_bf16(b0,qr[0],negm,0,0,0);p1=__builtin_amdgcn_mfma_f32_32x32x16_bf16(b1,qr[0],negm,0,0,0);}
    else{p0=__builtin_amdgcn_mfma_f32_32x32x16_bf16(b0,qr[d0],p0,0,0,0);p1=__builtin_amdgcn_mfma_f32_32x32x16_bf16(b1,qr[d0],p1,0,0,0);}}
}
typedef __attribute__((address_space(3))) const char* lds_cptr;
typedef short v4i16_t __attribute__((ext_vector_type(4)));
__device__ __forceinline__ void kload8(bf16x8*kf,lds_cptr kp){
  kf[0]=*(const __attribute__((address_space(3))) bf16x8*)(kp);      kf[1]=*(const __attribute__((address_space(3))) bf16x8*)(kp+512);
  kf[2]=*(const __attribute__((address_space(3))) bf16x8*)(kp+2048); kf[3]=*(const __attribute__((address_space(3))) bf16x8*)(kp+2560);
  kf[4]=*(const __attribute__((address_space(3))) bf16x8*)(kp+4096); kf[5]=*(const __attribute__((address_space(3))) bf16x8*)(kp+4608);
  kf[6]=*(const __attribute__((address_space(3))) bf16x8*)(kp+6144); kf[7]=*(const __attribute__((address_space(3))) bf16x8*)(kp+6656);
}
__device__ __forceinline__ void kload2(bf16x8*kf,lds_cptr kp,int j){ kf[2*j]=*(const __attribute__((address_space(3))) bf16x8*)(kp+j*2048); kf[2*j+1]=*(const __attribute__((address_space(3))) bf16x8*)(kp+j*2048+512); }
__device__ __forceinline__ s16x4 vtr(lds_cptr p){ return __builtin_bit_cast(s16x4,__builtin_amdgcn_ds_read_tr16_b64_v4i16((__attribute__((address_space(3))) v4i16_t*)p)); }
__device__ __forceinline__ float rowmax(const f32x16&p0,const f32x16&p1){
  float a=max3f(p0[0],p0[1],p1[0]),b=max3f(p0[2],p0[3],p1[1]);a=max3f(a,p1[2],p1[3]);
  #pragma unroll
  for(int r=4;r<16;r+=4){a=max3f(a,p0[r],p0[r+1]);b=max3f(b,p0[r+2],p0[r+3]);a=max3f(a,p1[r],p1[r+1]);b=max3f(b,p1[r+2],p1[r+3]);}
  const float m=max2f(a,b);
  auto rr=__builtin_amdgcn_permlane32_swap(__float_as_uint(m),__float_as_uint(m),false,false);
  return max2f(__uint_as_float(rr[0]),__uint_as_float(rr[1]));
}
__device__ __forceinline__ void pv(f32x16*o,int vb,bf16x8 pa0,bf16x8 pa1,bf16x8 pa2,bf16x8 pa3){
  #pragma unroll
  for(int d0=0;d0<2;++d0){s16x4 lo[4],hi[4];
    #pragma unroll
    for(int ks=0;ks<4;++ks){
      asm volatile("ds_read_b64_tr_b16 %0,%1 offset:%c2":"=&v"(lo[ks]):"v"(vb),"i"(d0*4096+ks*1024):"memory");
      asm volatile("ds_read_b64_tr_b16 %0,%1 offset:%c2":"=&v"(hi[ks]):"v"(vb),"i"(d0*4096+ks*1024+512):"memory");}
    asm volatile("s_waitcnt lgkmcnt(0)":::"memory");SBAR();
    #define PK(k) (bf16x8){lo[k][0],lo[k][1],lo[k][2],lo[k][3],hi[k][0],hi[k][1],hi[k][2],hi[k][3]}
    o[d0]=__builtin_amdgcn_mfma_f32_32x32x16_bf16(pa0,PK(0),o[d0],0,0,0);
    o[d0]=__builtin_amdgcn_mfma_f32_32x32x16_bf16(pa1,PK(1),o[d0],0,0,0);
    o[d0]=__builtin_amdgcn_mfma_f32_32x32x16_bf16(pa2,PK(2),o[d0],0,0,0);
    o[d0]=__builtin_amdgcn_mfma_f32_32x32x16_bf16(pa3,PK(3),o[d0],0,0,0);
    #undef PK
  }
}

#ifndef ATTN_STORE16
#define ATTN_STORE16(p,v) (*(u32x4*)(p)=(v))
#endif
__device__ __forceinline__ int fresh_lane(){ int l_; asm volatile("v_mbcnt_lo_u32_b32 %0, -1, 0\n\tv_mbcnt_hi_u32_b32 %0, -1, %0":"=v"(l_)); return l_; }
template<int MODE,int THRL> __device__ __forceinline__ void attn_unit(int b,int qb,const bf16*Q,const bf16*__restrict__ K,const bf16*__restrict__ V,void*O,const float*__restrict__ tblsrc,float slope2,char*shm,int wid){
  const int lane=fresh_lane(),tid=wid*64+lane,r32=lane&31,hi=lane>>5;
  const long rowbase=(long)b*SEQ; const int q0=qb*QB;
  const bf16*Qw=Q+(rowbase+q0+wid*QBLK)*DM;
  const bf16*Kh=K+rowbase*DM,*Vh=V+rowbase*DM;
  const lds_cptr shm3=(lds_cptr)shm;
  typedef __attribute__((address_space(3))) float* lds_fptr; typedef __attribute__((address_space(3))) const f32x4_t* lds_f4ptr;
  const unsigned lds0=(unsigned)(uintptr_t)shm;
  float*wsf=(float*)(shm+LDS_WS)+wid*64;
  const lds_fptr wsfu=(lds_fptr)(shm3+LDS_WS)+wid*64;
  const unsigned ksrc=(unsigned)(lane*DM+wid*8)*2u;
  const unsigned vsrc=(unsigned)((16*(wid&3)+(lane>>2))*DM+(wid>>2)*32+(lane&3)*8)*2u;
  const unsigned kdst=lds0+LDS_K+wid*1024, vdst=lds0+LDS_V+wid*1024;
  #define DMA_K(t,slot) glds16(Kh+(long)(t)*KVBLK*DM,ksrc,(unsigned)__builtin_amdgcn_readfirstlane(kdst+(slot)))
  #define DMA_V(t,slot) glds16(Vh+(long)(t)*KVBLK*DM,vsrc,(unsigned)__builtin_amdgcn_readfirstlane(vdst+(slot)))
  const int vb0=(int)(lds0+LDS_V)+((lane>>4)&1)*32+(lane&3)*8+(4*hi+((lane&15)>>2))*64;
  const char*Kbase=shm+LDS_K; bf16x8 kf[8];
  const lds_cptr kp0=shm3+LDS_K+hi*1024+r32*16; const lds_cptr vp0=shm3+LDS_V+((lane>>4)&1)*32+(lane&3)*8+(4*hi+((lane&15)>>2))*64;
  const int NT=(q0+QB)/KVBLK;
  DMA_K(0,0);DMA_V(0,0);DMA_K(1,SLOTB);
  const lds_fptr tbl=(lds_fptr)(shm3+LDS_TBL);
  for(int k=tid;k<q0+QB;k+=NW*64) tbl[k]=(MODE==0)?tblsrc[k]:slope2*(float)k;
  const float kbq=(MODE==0)?tblsrc[q0+wid*QBLK+r32]:slope2*(float)(q0+wid*QBLK+r32);
  const lds_f4ptr tb4=(lds_f4ptr)(shm3+LDS_TBL+16*hi);
  bf16x8 qr[4];
  #pragma unroll
  for(int d0=0;d0<4;++d0)qr[d0]=*reinterpret_cast<const bf16x8*>(&Qw[(long)r32*DM+d0*16+hi*8]);
  float mhat=0.f,l_reg=0.f;f32x16 o[2];o[0]=f32x16{};o[1]=f32x16{};const f32x16 zero16=f32x16{};
  const int qrel=wid*QBLK+r32;
  const int cw=wid>>1; const float s2x2=2.f*slope2;
  #define CMASK(P0,P1,t) do{int jb_=(t)-(NT-4); if(jb_>=0){ if(MODE==0)cmask(P0,P1,jb_,qrel,hi); else cmask_diff(P0,P1,jb_,qrel,hi,cw,s2x2);} }while(0)
  #define PIN(x) asm volatile("":"+v"(x))
  #define CINIT(C0,C1,t) do{ const lds_f4ptr tp_=tb4+(t)*16; \
    _Pragma("unroll") for(int g_=0;g_<4;++g_){ const f32x4_t a_=tp_[2*g_]; \
      _Pragma("unroll") for(int e_=0;e_<4;++e_) C0[4*g_+e_]=a_[e_]-mhat; } \
    PIN(C0); SBAR(); \
    _Pragma("unroll") for(int g_=0;g_<4;++g_){ const f32x4_t b_=tp_[8+2*g_]; \
      _Pragma("unroll") for(int e_=0;e_<4;++e_) C1[4*g_+e_]=b_[e_]-mhat; } \
    PIN(C1); }while(0)
  bool resc=false;
  #define START(P0,P1) do{ const float rm=rowmax(P0,P1); resc=false; \
    { mhat=rm+kbq; f32x16 c0_,c1_; CINIT(c0_,c1_,0); \
      _Pragma("unroll") for(int r=0;r<16;++r){P0[r]+=c0_[r];P1[r]+=c1_[r];} } \
    _Pragma("unroll") for(int r=0;r<16;++r)P0[r]=__builtin_amdgcn_exp2f(P0[r]); }while(0)
  #define RESC() do{ if(resc){ asm volatile("s_waitcnt lgkmcnt(0)":::"memory"); \
      _Pragma("unroll") for(int d_=0;d_<2;++d_) _Pragma("unroll") for(int r=0;r<16;++r)o[d_][r]*=wsf[crow(r,hi)]; } }while(0)
  f32x16 pA0,pA1,pB0,pB1;
  int sl_prev=0,sl_cur=0,sl_next=SLOTB;
  #define ROT() do{sl_prev=sl_cur;sl_cur=sl_next;sl_next=(sl_next==(NSLOT-1)*SLOTB)?0:sl_next+SLOTB;}while(0)
  DMA_K(2,2*SLOTB);
  WAIT_BAR(3);
  qkt(pA0,pA1,Kbase,qr,zero16,r32,hi);asm volatile("s_nop 15\n\ts_nop 7":"+v"(pA0),"+v"(pA1));CMASK(pA0,pA1,0);
  START(pA0,pA1);
  _Pragma("unroll") for(int r=0;r<16;++r)pA1[r]=__builtin_amdgcn_exp2f(pA1[r]);
  WAIT_BAR(0);
  DMA_K(3,0);DMA_V(1,SLOTB);
  ROT();
  kload8(kf,kp0+sl_cur);
  WAIT_BAR(2);
  s16x4 vlo[8],vhi[8]; u32x4 pw0,pw1,pw2,pw3;
  #define PKW(P,B) cvtpk_s(P[B],P[B+1])
  #define PAF(k) __builtin_bit_cast(bf16x8,pw##k)
  #define VFR(i) (bf16x8){vlo[i][0],vlo[i][1],vlo[i][2],vlo[i][3],vhi[i][0],vhi[i][1],vhi[i][2],vhi[i][3]}
  #define MX3(a,b,c) __builtin_fmaxf(__builtin_fmaxf((a),(b)),(c))
  #define GAPA(MF,A0,A1,A2,A3,W0,W1,PW) do{ MF; sacc+=A0; sacc+=A1; sacc+=A2; sacc+=A3; PIN(sacc); W0; W1; PIN(PW); SBAR(); }while(0)
  #define EX(v) __builtin_amdgcn_exp2f(v)
  #define GAPB(MF,X,B) do{ MF; X[B]=EX(X[B]); X[B+1]=EX(X[B+1]); X[B+2]=EX(X[B+2]); X[B+3]=EX(X[B+3]); PIN(X); SBAR(); }while(0)
  #define VRD(i) do{ vlo[i]=vtr(vp_+(((i)>>2)*4096+((i)&3)*1024)); vhi[i]=vtr(vp_+(((i)>>2)*4096+((i)&3)*1024+512)); }while(0)
  #define KRD(G,j) do{ if(G){ kload2(kf,kp0+sl_next,j); SBAR(); } }while(0)
  #define STEP(C0,C1,P0,P1,t,GK,GV,GL) do{ SBAR(); \
    CINIT(C0,C1,t); SBAR(); \
    const lds_cptr vp_=vp0+sl_prev; \
    VRD(0); SBAR(); float sacc=(P0[0]+P0[1]); \
    GAPA(C0=__builtin_amdgcn_mfma_f32_32x32x16_bf16(kf[0],qr[0],C0,0,0,0), P0[2],P0[3],P0[4],P0[5],     pw0[0]=PKW(P0,0), pw0[1]=PKW(P0,2), pw0); \
    VRD(4); SBAR(); GAPA(C1=__builtin_amdgcn_mfma_f32_32x32x16_bf16(kf[1],qr[0],C1,0,0,0), P0[6],P0[7],P0[8],P0[9],     pw0[2]=PKW(P0,4), pw0[3]=PKW(P0,6), pw0); \
    VRD(1); SBAR(); GAPA(C0=__builtin_amdgcn_mfma_f32_32x32x16_bf16(kf[2],qr[1],C0,0,0,0),   P0[10],P0[11],P0[12],P0[13], pw1[0]=PKW(P0,8), pw1[1]=PKW(P0,10), pw1); \
    VRD(5); SBAR(); GAPA(C1=__builtin_amdgcn_mfma_f32_32x32x16_bf16(kf[3],qr[1],C1,0,0,0),   P0[14],P0[15],P1[0],P1[1],   pw1[2]=PKW(P0,12),pw1[3]=PKW(P0,14), pw1); \
    VRD(2); SBAR(); GAPA(C0=__builtin_amdgcn_mfma_f32_32x32x16_bf16(kf[4],qr[2],C0,0,0,0),   P1[2],P1[3],P1[4],P1[5],     pw2[0]=PKW(P1,0), pw2[1]=PKW(P1,2), pw2); \
    VRD(6); SBAR(); GAPA(C1=__builtin_amdgcn_mfma_f32_32x32x16_bf16(kf[5],qr[2],C1,0,0,0),   P1[6],P1[7],P1[8],P1[9],     pw2[2]=PKW(P1,4), pw2[3]=PKW(P1,6), pw2); \
    VRD(3); SBAR(); GAPA(C0=__builtin_amdgcn_mfma_f32_32x32x16_bf16(kf[6],qr[3],C0,0,0,0),   P1[10],P1[11],P1[12],P1[13], pw3[0]=PKW(P1,8), pw3[1]=PKW(P1,10), pw3); \
    VRD(7); SBAR(); GAPA(C1=__builtin_amdgcn_mfma_f32_32x32x16_bf16(kf[7],qr[3],C1,0,0,0),   P1[14],P1[15],0.f,0.f,       pw3[2]=PKW(P1,12),pw3[3]=PKW(P1,14), pw3); \
    l_reg+=sacc; \
    if(GK){DMA_K((t)+3,sl_cur);} if(GV){DMA_V((t)+1,sl_next);} \
    CMASK(C0,C1,t); \
    { float a=MX3(C0[0],C0[1],C1[0]),b=MX3(C0[2],C0[3],C1[1]); a=MX3(a,C1[2],C1[3]); \
      _Pragma("unroll") for(int r=4;r<16;r+=4){a=MX3(a,C0[r],C0[r+1]);b=MX3(b,C0[r+2],C0[r+3]);a=MX3(a,C1[r],C1[r+1]);b=MX3(b,C1[r+2],C1[r+3]);} \
      float rm=__builtin_fmaxf(a,b); { auto rr=__builtin_amdgcn_permlane32_swap(__float_as_uint(rm),__float_as_uint(rm),false,false); rm=__builtin_fmaxf(__uint_as_float(rr[0]),__uint_as_float(rr[1])); } \
      resc=false; \
      if(__builtin_expect(__any(rm>(float)THRL),0)){ const float dl=__builtin_fmaxf(rm,0.f); mhat+=dl; \
        _Pragma("unroll") for(int r=0;r<16;++r){C0[r]-=dl;C1[r]-=dl;} \
        const float f=__builtin_amdgcn_exp2f(-dl); l_reg*=f; { const int ln_=fresh_lane(); if(ln_<32)wsfu[ln_]=f; } resc=true; } } \
    SBAR(); \
    GAPB(o[0]=__builtin_amdgcn_mfma_f32_32x32x16_bf16(PAF(0),VFR(0),o[0],0,0,0), C0,0); \
    GAPB(o[1]=__builtin_amdgcn_mfma_f32_32x32x16_bf16(PAF(0),VFR(4),o[1],0,0,0), C0,4); \
    KRD(GL,0); GAPB(o[0]=__builtin_amdgcn_mfma_f32_32x32x16_bf16(PAF(1),VFR(1),o[0],0,0,0), C0,8); \
    KRD(GL,1); GAPB(o[1]=__builtin_amdgcn_mfma_f32_32x32x16_bf16(PAF(1),VFR(5),o[1],0,0,0), C0,12); \
    KRD(GL,2); GAPB(o[0]=__builtin_amdgcn_mfma_f32_32x32x16_bf16(PAF(2),VFR(2),o[0],0,0,0), C1,0); \
    KRD(GL,3); GAPB(o[1]=__builtin_amdgcn_mfma_f32_32x32x16_bf16(PAF(2),VFR(6),o[1],0,0,0), C1,4); \
    GAPB(o[0]=__builtin_amdgcn_mfma_f32_32x32x16_bf16(PAF(3),VFR(3),o[0],0,0,0), C1,8); \
    GAPB(o[1]=__builtin_amdgcn_mfma_f32_32x32x16_bf16(PAF(3),VFR(7),o[1],0,0,0), C1,12); \
    }while(0)
  int t=1;
  #undef CMASK
  #define CMASK(P0,P1,t) do{}while(0)
  for(;t+5<NT;t+=2){
    STEP(pB0,pB1,pA0,pA1,t,true,true,true);     WAIT_BAR(2); RESC(); ROT();
    STEP(pA0,pA1,pB0,pB1,t+1,true,true,true);   WAIT_BAR(2); RESC(); ROT();
  }
  #undef CMASK
  #define CMASK(P0,P1,t) do{int jb_=(t)-(NT-4); if(jb_>=0){ if(MODE==0)cmask(P0,P1,jb_,qrel,hi); else cmask_diff(P0,P1,jb_,qrel,hi,cw,s2x2);} }while(0)
  #define ENDW(tt) do{ if((tt)+3<NT){WAIT_BAR(2);} else if((tt)+2<NT){WAIT_BAR(1);} else {WAIT_BAR(0);} }while(0)
  for(;t+1<NT;t+=2){
    STEP(pB0,pB1,pA0,pA1,t,(t+3<NT),(t+1<NT),(t+1<NT));       ENDW(t);   RESC(); ROT();
    STEP(pA0,pA1,pB0,pB1,t+1,(t+4<NT),(t+2<NT),(t+2<NT));     ENDW(t+1); RESC(); ROT();
  }
  STEP(pB0,pB1,pA0,pA1,NT-1,false,false,false); RESC();
  { float sacc=pB0[0]+pB0[1]; _Pragma("unroll") for(int r=2;r<16;++r)sacc+=pB0[r]; _Pragma("unroll") for(int r=0;r<16;++r)sacc+=pB1[r]; l_reg+=sacc;
    pw0=(u32x4){PKW(pB0,0),PKW(pB0,2),PKW(pB0,4),PKW(pB0,6)};pw1=(u32x4){PKW(pB0,8),PKW(pB0,10),PKW(pB0,12),PKW(pB0,14)};pw2=(u32x4){PKW(pB1,0),PKW(pB1,2),PKW(pB1,4),PKW(pB1,6)};pw3=(u32x4){PKW(pB1,8),PKW(pB1,10),PKW(pB1,12),PKW(pB1,14)};
    SBAR(); pv(o,vb0+sl_cur,PAF(0),PAF(1),PAF(2),PAF(3)); }
  #undef PKW
  #undef PAF
  #undef VFR
  #undef PIN
  #undef MX3
  #undef GAPA
  #undef GAPB
  #undef EX
  #undef VRD
  #undef KRD
  #undef STEP
  #undef ENDW
  {auto rr=__builtin_amdgcn_permlane32_swap(__float_as_uint(l_reg),__float_as_uint(l_reg),false,false);l_reg=__uint_as_float(rr[0])+__uint_as_float(rr[1]);}
  const int lane_e=fresh_lane(),r32_e=lane_e&31,hi_e=lane_e>>5;
  if(hi_e==0)wsfu[32+r32_e]=l_reg;asm volatile("s_waitcnt lgkmcnt(0)":::"memory");
  float rli[16];
  #pragma unroll
  for(int r=0;r<16;++r)rli[r]=__builtin_amdgcn_rcpf(wsfu[32+crow(r,hi_e)]);
  if(MODE==1){ typedef __attribute__((address_space(1))) float* gfptr; gfptr Of=(gfptr)((float*)O+(rowbase+q0+wid*QBLK+4*hi_e)*1024+r32_e);
    #pragma unroll
    for(int r=0;r<16;++r){ asm volatile("":"+v"(Of)); Of[0]=o[0][r]*rli[r]; Of[32]=o[1][r]*rli[r]; Of+=((r&3)==3)?5*1024:1024; } }
  else{ bf16*Ow=(bf16*)O+(rowbase+q0+wid*QBLK)*DM;
    bf16*stg=(bf16*)(shm+LDS_OST)+wid*2048;
    #pragma unroll
    for(int r=0;r<16;++r){const int orow=crow(r,hi_e);
      #pragma unroll
      for(int d0=0;d0<2;++d0)stg[orow*64+d0*32+r32_e]=__float2bfloat16(o[d0][r]*rli[r]);}
    asm volatile("s_waitcnt lgkmcnt(0)":::"memory");
    #pragma unroll
    for(int i=0;i<4;++i){const int row=i*8+(lane_e>>3),ch=lane_e&7; const u32x4 v=*(const u32x4*)(stg+row*64+ch*8); ATTN_STORE16(Ow+(long)row*DM+ch*8,v);} }
  asm volatile("s_waitcnt lgkmcnt(0)\n\ts_barrier":::"memory");
  #undef DMA_K
  #undef DMA_V
  #undef CMASK
  #undef CINIT
  #undef START
  #undef RESC
  #undef ROT
}
constexpr int ATTN_LDS_BYTES=LDS_BYTES;
#undef SBAR
#undef WAIT_BAR
}
constexpr int SA_NCH = 17;
constexpr size_t WS_PARTF = WS_END;
constexpr size_t WS_PARTD = WS_PARTF + (size_t)64 * SA_NCH * 16 * 66 * 4;
constexpr size_t WS_END2 = WS_PARTD + (size_t)64 * SA_NCH * 16 * 130 * 4;
typedef short sbf16x8 __attribute__((ext_vector_type(8)));
__device__ __forceinline__ sbf16x8 cvt8(const f32x4 a, const f32x4 b) { v4u w; w.x = pg8::cvt_pk_bf16(a.x, a.y); w.y = pg8::cvt_pk_bf16(a.z, a.w); w.z = pg8::cvt_pk_bf16(b.x, b.y); w.w = pg8::cvt_pk_bf16(b.z, b.w); return __builtin_bit_cast(sbf16x8, w); }
template <int KIND  , class AP> __device__ __forceinline__ void sample_attn_unit(Frame& F, const AP A, int l, int b, int h, int chunk) {
    constexpr int NC = KIND ? 2 : 1, VD = KIND ? 128 : 64, NDT = VD / 16, PW = VD + 2;
    unsigned char* ws = GWS(A);
    const int lane = F.lane, g = lane >> 4, n = lane & 15, wid = F.wave;
    const bool isnew = chunk == 16, active = !isnew || wid == 0;
    const int kbase = isnew ? 0 : chunk * 256 + wid * 32;
    const bf16* Qb = (const bf16*)(ws + (KIND ? WS_QB : WS_QA)) + (size_t)(MP + b * SSEQ + n) * 512 + (KIND ? h * 128 : h * 64) + 8 * g;
    const float* Kc = GIN(A, KIND ? I_CDK : I_CFK) + ((size_t)(l * SBATCH + b) * PAST) * 512 + (KIND ? h * 128 : h * 64);
    const float* Vc = GIN(A, KIND ? I_CDV : I_CFV) + ((size_t)(l * SBATCH + b) * PAST) * 512 + (KIND ? h * 128 : h * 64);
    const bf16* Kn = (const bf16*)(ws + (KIND ? WS_KB : WS_KA)) + (size_t)(MP + b * SSEQ) * 512 + (KIND ? h * 128 : h * 64);
    const bf16* Vn = (const bf16*)(ws + (KIND ? WS_VB : WS_VA)) + (size_t)(MP + b * SSEQ) * 512 + (KIND ? h * 128 : h * 64);
    const float slope2 = exp2f(-2.0f * (float)(h + 1)) * LOG2E;
    f32x4 oT[NC][NDT]; float mw[NC], lw[NC];
#pragma unroll
    for (int c = 0; c < NC; ++c) { mw[c] = -1e30f; lw[c] = 0.f;
#pragma unroll
        for (int dt = 0; dt < NDT; ++dt) oT[c][dt] = (f32x4){0.f, 0.f, 0.f, 0.f}; }
    if (active) {
        sbf16x8 pf[NC];
#pragma unroll
        for (int c = 0; c < NC; ++c) {
            f32x4 s[2];
#pragma unroll
            for (int kt = 0; kt < 2; ++kt) { f32x4 acc = (f32x4){0.f, 0.f, 0.f, 0.f};
#pragma unroll
                for (int ks = 0; ks < 2; ++ks) { sbf16x8 kf; const int key = kbase + 16 * kt + n;
                    if (!isnew) { const float* p = Kc + (size_t)key * 512 + c * 64 + 32 * ks + 8 * g; kf = cvt8(*(const GAS f32x4*)p, *(const GAS f32x4*)(p + 4)); }
                    else kf = *(const GAS sbf16x8*)(Kn + (size_t)(key & 15) * 512 + c * 64 + 32 * ks + 8 * g);
                    const sbf16x8 qf = *(const GAS sbf16x8*)(Qb + c * 64 + 32 * ks);
                    acc = __builtin_amdgcn_mfma_f32_16x16x32_bf16(kf, qf, acc, 0, 0, 0); }
                s[kt] = acc; }
            float mx = -1e30f;
#pragma unroll
            for (int kt = 0; kt < 2; ++kt)
#pragma unroll
                for (int i = 0; i < 4; ++i) { const int kk = 16 * kt + 4 * g + i; float bias; bool vis = true;
                    if (KIND == 0) { if (!isnew) bias = -((const float*)(ws + WS_CP))[((size_t)(l * 8 + b) * 8 + h) * PAST + kbase + kk] * LOG2E;
                                     else { bias = ((const float*)(ws + WS_CKS))[(b * 8 + h) * SSEQ + (kk & 15)]; vis = kk <= n; } }
                    else { const int kpos = isnew ? PAST + kk : kbase + kk; bias = -slope2 * fabsf((float)(PAST + n - kpos)); if (isnew) vis = kk < 16; }
                    const float v = vis ? s[kt][i] + bias : -1e30f; s[kt][i] = v; mx = fmaxf(mx, v); }
            mx = fmaxf(mx, lane_get(mx, lane ^ 16)); mx = fmaxf(mx, lane_get(mx, lane ^ 32));
            float sum = 0.f;
#pragma unroll
            for (int kt = 0; kt < 2; ++kt)
#pragma unroll
                for (int i = 0; i < 4; ++i) { const float p = exp2f(s[kt][i] - mx); s[kt][i] = p; sum += p; }
            sum += lane_get(sum, lane ^ 16); sum += lane_get(sum, lane ^ 32);
            mw[c] = mx; lw[c] = sum; pf[c] = cvt8(s[0], s[1]);
        }
#pragma unroll
        for (int dt = 0; dt < NDT; ++dt) { f32x4 v0, v1;
#pragma unroll
            for (int j = 0; j < 4; ++j) { const int k0 = 4 * g + j, k1 = 16 + 4 * g + j;
                if (!isnew) { v0[j] = *(const GAS float*)(Vc + (size_t)(kbase + k0) * 512 + 16 * dt + n); v1[j] = *(const GAS float*)(Vc + (size_t)(kbase + k1) * 512 + 16 * dt + n); }
                else { v0[j] = epi::bf2f(*(const GAS unsigned short*)(Vn + (size_t)(k0 & 15) * 512 + 16 * dt + n)); v1[j] = epi::bf2f(*(const GAS unsigned short*)(Vn + (size_t)(k1 & 15) * 512 + 16 * dt + n)); } }
            const sbf16x8 vf = cvt8(v0, v1);
#pragma unroll
            for (int c = 0; c < NC; ++c) oT[c][dt] = __builtin_amdgcn_mfma_f32_16x16x32_bf16(vf, pf[c], oT[c][dt], 0, 0, 0); }
    }
    LAS float* ML = (LAS float*)(F.lds + RING_OFF); LAS float* OT = ML + 8 * 32;
#pragma unroll
    for (int c = 0; c < NC; ++c) {
        if (g == 0) { ML[wid * 32 + n] = mw[c]; ML[wid * 32 + 16 + n] = lw[c]; }
#pragma unroll
        for (int dt = 0; dt < NDT; ++dt)
#pragma unroll
            for (int i = 0; i < 4; ++i) OT[wid * (VD * 16) + (16 * dt + 4 * g + i) * 16 + n] = oT[c][dt][i];
        __syncthreads();
        float* part = (float*)(ws + (KIND ? WS_PARTD : WS_PARTF)) + ((size_t)((KIND ? ((b * 4 + h) * 2 + c) : (b * 8 + h)) * SA_NCH + chunk) * 16) * PW;
        for (int e = F.tid; e < VD * 16; e += NWAVES * 64) { const int q = e & 15, d = e >> 4; float M = -1e30f;
#pragma unroll
            for (int w = 0; w < 8; ++w) M = fmaxf(M, ML[w * 32 + q]);
            float num = 0.f, L = 0.f;
#pragma unroll
            for (int w = 0; w < 8; ++w) { const float f = exp2f(ML[w * 32 + q] - M); num += f * OT[w * (VD * 16) + e]; L += f * ML[w * 32 + 16 + q]; }
            part[q * PW + 2 + d] = num; if (d == 0) { part[q * PW] = M; part[q * PW + 1] = L; } }
        __syncthreads();
    }
}
template <class AP> __device__ __forceinline__ void sample_attn_phase(Frame& F, const AP A, int l) {
    for (int u = F.vcu; u < 512 + 1024 + 96; u += F.G) {
        if (u < 512) sample_attn_unit<1>(F, A, l, u >> 6, (u >> 4) & 3, u & 15);
        else if (u < 1536) { const int v = u - 512; sample_attn_unit<0>(F, A, l, v >> 7, (v >> 4) & 7, v & 15); }
        else if (u < 1568) { const int v = u - 1536; sample_attn_unit<1>(F, A, l, v >> 2, v & 3, 16); }
        else { const int v = u - 1568; sample_attn_unit<0>(F, A, l, v >> 3, v & 7, 16); }
    }
}
template <class AP> __device__ __forceinline__ void sample_finalize(Frame& F, const AP A, int l) {
    unsigned char* ws = GWS(A);
    const int gw = F.vcu * NWAVES + F.wave, NGW = F.G * NWAVES, lane = F.lane;
    const float li = lambda_init_of(l);
    const float d1 = wave_sum(GIN(A, I_LQ1)[l * 64 + lane] * GIN(A, I_LK1)[l * 64 + lane], lane), d2 = wave_sum(GIN(A, I_LQ2)[l * 64 + lane] * GIN(A, I_LK2)[l * 64 + lane], lane);
    const float lam = __expf(d1) - __expf(d2) + li;
    for (int r = gw; r < MS; r += NGW) { const int b = r >> 4, q = r & 15, row = MP + r;
        {
            const int h = lane >> 3, d0 = (lane & 7) * 8; const float* part = (const float*)(ws + WS_PARTF) + ((size_t)(b * 8 + h) * SA_NCH * 16 + q) * 66;
            float M = -1e30f;
            for (int ch = 0; ch < SA_NCH; ++ch) M = fmaxf(M, part[(size_t)ch * 16 * 66]);
            f32x4 a0 = {0.f, 0.f, 0.f, 0.f}, a1 = a0; float L = 0.f;
            for (int ch = 0; ch < SA_NCH; ++ch) { const float* p = part + (size_t)ch * 16 * 66; const float f = exp2f(p[0] - M); L += f * p[1];
#pragma unroll
                for (int e = 0; e < 4; ++e) { a0[e] += f * p[2 + d0 + e]; a1[e] += f * p[2 + d0 + 4 + e]; } }
            const float inv = 1.0f / L; a0 = a0 * inv; a1 = a1 * inv;
            v4u o; o.x = pk2(a0.x, a0.y); o.y = pk2(a0.z, a0.w); o.z = pk2(a1.x, a1.y); o.w = pk2(a1.z, a1.w);
            *(GAS v4u*)((bf16*)(ws + WS_OA) + (size_t)row * 512 + h * 64 + d0) = o; }
        {
            const int h = lane >> 4, e0 = (lane & 15) * 8; f32x4 oc[2][2];
#pragma unroll
            for (int c = 0; c < 2; ++c) { const float* part = (const float*)(ws + WS_PARTD) + ((size_t)((b * 4 + h) * 2 + c) * SA_NCH * 16 + q) * 130;
                float M = -1e30f;
                for (int ch = 0; ch < SA_NCH; ++ch) M = fmaxf(M, part[(size_t)ch * 16 * 130]);
                f32x4 a0 = {0.f, 0.f, 0.f, 0.f}, a1 = a0; float L = 0.f;
                for (int ch = 0; ch < SA_NCH; ++ch) { const float* p = part + (size_t)ch * 16 * 130; const float f = exp2f(p[0] - M); L += f * p[1];
#pragma unroll
                    for (int e = 0; e < 4; ++e) { a0[e] += f * p[2 + e0 + e]; a1[e] += f * p[2 + e0 + 4 + e]; } }
                const float inv = 1.0f / L; oc[c][0] = a0 * inv; oc[c][1] = a1 * inv; }
            f32x4 g0 = *(const GAS f32x4*)(GIN(A, I_GD) + l * 512 + h * 128 + e0), g1 = *(const GAS f32x4*)(GIN(A, I_GD) + l * 512 + h * 128 + e0 + 4);
            f32x4 a0 = oc[0][0] - oc[1][0] * lam, a1 = oc[0][1] - oc[1][1] * lam;
            float ss = (a0.x * a0.x + a0.y * a0.y) + (a0.z * a0.z + a0.w * a0.w) + (a1.x * a1.x + a1.y * a1.y) + (a1.z * a1.z + a1.w * a1.w);
            ss += lane_get(ss, lane ^ 1); ss += lane_get(ss, lane ^ 2); ss += lane_get(ss, lane ^ 4); ss += lane_get(ss, lane ^ 8);
            const float rr = 1.0f / sqrtf(ss * (1.0f / 128.0f) + RMS_EPS) * (1.0f - li);
            a0 = a0 * rr * g0; a1 = a1 * rr * g1;
            v4u o; o.x = pk2(a0.x, a0.y); o.y = pk2(a0.z, a0.w); o.z = pk2(a1.x, a1.y); o.w = pk2(a1.z, a1.w);
            *(GAS v4u*)((bf16*)(ws + WS_OB) + (size_t)row * 512 + h * 128 + e0) = o; }
    }
}
struct SOp { const bf16* A; int lda; const bf16* Bt; int K; };
template <int NB, class RowMap, class Fn>
__device__ __forceinline__ void sgemm_phase(Frame& F, int cu, const SOp (&op)[NB], int nunits, const RowMap& brow, const Fn& f) {
    const int lane = F.lane, g = lane >> 4, n = lane & 15, wid = F.wave;
    LAS float* red = (LAS float*)(F.lds + RING_OFF);
    for (int u = cu; u < nunits; u += F.G) {
        f32x4 acc[NB][8];
#pragma unroll
        for (int j = 0; j < NB; ++j)
#pragma unroll
            for (int rt = 0; rt < 8; ++rt) acc[j][rt] = (f32x4){0.f, 0.f, 0.f, 0.f};
#pragma unroll
        for (int j = 0; j < NB; ++j) { const int K = op[j].K, kw = K >> 3, k0 = wid * kw;
            const bf16* ap = op[j].A + (size_t)n * op[j].lda + k0 + 8 * g; const bf16* bp = op[j].Bt + (size_t)(brow(u, j) + n) * K + k0 + 8 * g;
            for (int ks = 0; ks < kw; ks += 32) { const sbf16x8 bf = *(const GAS sbf16x8*)(bp + ks);
#pragma unroll
                for (int rt = 0; rt < 8; ++rt) { const sbf16x8 af = *(const GAS sbf16x8*)(ap + (size_t)(rt * 16) * op[j].lda + ks);
                    acc[j][rt] = __builtin_amdgcn_mfma_f32_16x16x32_bf16(af, bf, acc[j][rt], 0, 0, 0); } } }
#pragma unroll
        for (int j = 0; j < NB; ++j)
#pragma unroll
            for (int rt = 0; rt < 8; ++rt)
#pragma unroll
                for (int i = 0; i < 4; ++i) red[((wid * NB + j) * 128 + rt * 16 + 4 * g + i) * 16 + n] = acc[j][rt][i];
        __syncthreads();
        for (int e = F.tid; e < 2048; e += NWAVES * 64) { float v[2] = {0.f, 0.f};
#pragma unroll
            for (int j = 0; j < NB; ++j)
#pragma unroll
                for (int w = 0; w < 8; ++w) v[j] += red[(w * NB + j) * 2048 + e];
            f(e >> 4, u, e & 15, v[0], v[1]); }
        __syncthreads();
    }
}
struct RowLinear { __device__ __forceinline__ int operator()(int u, int) const { return 16 * u; } };
struct RowGateUp { __device__ __forceinline__ int operator()(int u, int j) const { return (u >> 3) * 256 + (u & 7) * 16 + j * 128; } };
struct NaiveArgs { const float* in[N_IN]; unsigned char* ws; int layer, sample, mode, pad; };
template <int VD>
__global__ void __launch_bounds__(64) naive_attn(NaiveArgs a) {
    __shared__ float Ks[32][64]; __shared__ float Vs[32][VD]; __shared__ float Bs[32];
    const int tid = threadIdx.x, qblk = blockIdx.x, vh = blockIdx.y, b = blockIdx.z, l = a.layer;
    const bool fox = a.mode == 0; unsigned char* ws = a.ws;
    const int n0 = a.sample ? PAST : 0, nq = a.sample ? SSEQ : 64;
    const int rowb = a.sample ? MP + b * SSEQ : b * SEQ;
    const int qi = qblk * 64 + tid;
    const int qpos = n0 + qi; const bool qact = tid < nq;
    const int n1 = a.sample ? SSEQ : (qblk + 1) * 64;
    const int h = fox ? vh : (vh >> 1), qcol = fox ? h * 64 : h * 128 + (vh & 1) * 64, vcol = fox ? h * 64 : h * 128;
    const bf16* Q = (const bf16*)(ws + (fox ? WS_QA : WS_QB)); const bf16* K1 = (const bf16*)(ws + (fox ? WS_KA : WS_KB)); const bf16* V1 = (const bf16*)(ws + (fox ? WS_VA : WS_VB));
    const float* K0 = a.in[fox ? I_CFK : I_CDK] + (size_t)(l * SBATCH + b) * PAST * 512 + qcol; const float* V0 = a.in[fox ? I_CFV : I_CDV] + (size_t)(l * SBATCH + b) * PAST * 512 + vcol;
    const float* CP = (const float*)(ws + WS_CP) + ((size_t)(l * 8 + b) * 8 + h) * PAST;
    const float* CK1 = a.sample ? (const float*)(ws + WS_CKS) + (b * 8 + h) * SSEQ : (const float*)(ws + WS_CKP) + (size_t)(b * 8 + h) * SEQ;
    const float slope2 = exp2f(-2.0f * (float)(h + 1)) * LOG2E;
    float q[64];
#pragma unroll
    for (int d = 0; d < 64; ++d) q[d] = qact ? epi::bf2f(Q[(size_t)(rowb + qi) * 512 + qcol + d]) : 0.f;
    float o[VD];
#pragma unroll
    for (int e = 0; e < VD; ++e) o[e] = 0.f;
    float mrun = -1e30f, lrun = 0.f;
    const int ntot = n0 + n1;
    for (int k0 = 0; k0 < ntot; k0 += 32) {
        __syncthreads();
        for (int j = 0; j < 32; ++j) { const int k = k0 + j; float kv = 0.f;
            if (k < ntot) kv = k < n0 ? K0[(size_t)k * 512 + tid] : epi::bf2f(K1[(size_t)(rowb + k - n0) * 512 + qcol + tid]);
            Ks[j][tid] = kv;
            for (int e = tid; e < VD; e += 64) { float vv = 0.f; if (k < ntot) vv = k < n0 ? V0[(size_t)k * 512 + e] : epi::bf2f(V1[(size_t)(rowb + k - n0) * 512 + vcol + e]); Vs[j][e] = vv; } }
        if (tid < 32) { const int k = k0 + tid; float bb = 0.f; if (fox && k < ntot) bb = k < n0 ? -CP[k] * LOG2E : CK1[k - n0]; Bs[tid] = bb; }
        __syncthreads();
        float s[32]; float tmax = -1e30f;
#pragma unroll
        for (int j = 0; j < 32; ++j) { const int k = k0 + j; float acc = 0.f;
#pragma unroll
            for (int d = 0; d < 64; ++d) acc += q[d] * Ks[j][d];
            bool vis = k < ntot && (fox ? (k <= qpos) : ((k >> 6) <= (qpos >> 6)));
            acc += fox ? Bs[j] : -slope2 * fabsf((float)(qpos - k));
            s[j] = vis ? acc : -1e30f; tmax = fmaxf(tmax, s[j]); }
        const float mnew = fmaxf(mrun, tmax), sc = exp2f(mrun - mnew);
        lrun *= sc;
#pragma unroll
        for (int e = 0; e < VD; ++e) o[e] *= sc;
#pragma unroll
        for (int j = 0; j < 32; ++j) { const float p = s[j] > -1e29f ? exp2f(s[j] - mnew) : 0.f; lrun += p;
#pragma unroll
            for (int e = 0; e < VD; ++e) o[e] += p * Vs[j][e]; }
        mrun = mnew;
    }
    if (qact) { const float inv = 1.0f / lrun;
        if (fox) { bf16* O = (bf16*)(ws + WS_OA) + (size_t)(rowb + qi) * 512 + h * 64;
#pragma unroll
            for (int e = 0; e < VD; ++e) O[e] = (bf16)f2bf(o[e] * inv);
        } else { float* O = (float*)(ws + WS_O12) + (size_t)(rowb + qi) * DM + vh * 128;
#pragma unroll
            for (int e = 0; e < VD; ++e) O[e] = o[e] * inv; } }
}
__device__ __forceinline__ void prompt_attn_phase(char* lds, unsigned char* ws, int vcu, int G, int wid) {
    typedef attn_body::bf16 abf;
    for (int P = vcu; P < 256; P += G) { const int stream = P >> 2, s = P & 3, b = stream >> 3, h = stream & 7;
        for (int w = 0; w < 2; ++w) attn_body::attn_unit<0, 8>(b, w ? s : 7 - s, (const abf*)(ws + WS_QA) + h * 64, (const abf*)(ws + WS_KA) + h * 64, (const abf*)(ws + WS_VA) + h * 64, (abf*)(ws + WS_OA) + h * 64,
                                                                (const float*)(ws + WS_CKP) + (size_t)stream * SEQ, 0.f, lds, wid); }
    for (int P = vcu; P < 512; P += G) { const int stream = P >> 2, s = P & 3, b = stream >> 4, h = (stream >> 2) & 3, c = (stream >> 1) & 1, vh = stream & 1;
        const float slope2 = exp2f(-2.0f * (float)(h + 1)) * LOG2E;
        for (int w = 0; w < 2; ++w) attn_body::attn_unit<1, 8>(b, w ? s : 7 - s, (const abf*)(ws + WS_QB) + h * 128 + c * 64, (const abf*)(ws + WS_KB) + h * 128 + c * 64, (const abf*)(ws + WS_VB) + h * 128 + vh * 64,
                                                                (float*)(ws + WS_O12) + (h * 2 + c) * 128 + vh * 64, nullptr, slope2, lds, wid); }
}
constexpr int NPH = 12;
constexpr int NPHASES = 1 + DEPTH * NPH;
#ifndef MK_ATTN_NAIVE
#define MK_ATTN_NAIVE 0
#endif
__global__ void __launch_bounds__(NWAVES * 64, 2) mk_fwd(Args args_by_value) {
    typedef __attribute__((address_space(4))) const Args* kargs_t;
    kargs_t ap = (kargs_t)__builtin_amdgcn_kernarg_segment_ptr();
#define args ap
    extern __shared__ __attribute__((aligned(16))) unsigned char lds[];
    Frame F;
    F.lds = (LAS unsigned char*)lds; F.MISC = (volatile LAS unsigned*)(F.lds + MISC_OFF);
    F.tid = threadIdx.x; F.lane = F.tid & 63; F.wave = __builtin_amdgcn_readfirstlane(F.tid >> 6);
    F.G = gridDim.x; { const int bx = blockIdx.x; F.vcu = (F.G % 8 == 0) ? (bx % 8) * (F.G / 8) + bx / 8 : bx; }
    GAS unsigned char* wsg = (GAS unsigned char*)args->ws; unsigned char* ws = (unsigned char*)wsg; F.ctl = (gu32*)(ws + WS_CTL); int bx = blockIdx.x;
    for (int u = F.tid; u < (LDS_BYTES - LDSCTL_OFF) / 4; u += NWAVES * 64) ((LAS unsigned*)(F.lds + LDSCTL_OFF))[u] = 0u;
    __syncthreads();
    const int lo = args->ph_lo, hi = args->ph_hi;
    const bool multi = (hi - lo) > 1;
    XcdBarrier bar; bar.bar = (unsigned*)(F.ctl + CW_BAR); bar.x = 0; bar.st = nullptr;
    if (multi) bar = xcd_barrier_post((unsigned*)(F.ctl + CW_BAR), F.MISC + 8);
#define IN(k) (lo <= (k) && (k) < hi)
#define FRESH() do { int l_; asm volatile("v_mbcnt_lo_u32_b32 %0, -1, 0\n\tv_mbcnt_hi_u32_b32 %0, -1, %0" : "=v"(l_)); F.lane = l_; F.tid = F.wave * 64 + l_; asm volatile("" : "+s"(F.G), "+s"(bx), "+s"(wsg), "+s"(ap)); ws = (unsigned char*)wsg; } while (0)
#define SEAM(k) do { if (IN(k) && IN((k) + 1)) xcd_barrier(bar); } while (0)
    if (IN(0)) { p0_prologue(F, args); SEAM(0); }
    for (int l = 0; l < DEPTH; ++l) {
        const int p0 = 1 + l * NPH;
        unsigned char* wl = ws + WS_W + (size_t)l * WL_SIZE;
        if (IN(p0 + 0)) { FRESH();
            pg8::Gemm g{(const bf16*)(ws + WS_XB), (const bf16*)(wl + WL_IN), MP, NPROJ, DM}; pg8::StaticOrder S; S.init(MP, NPROJ, F.G, bx);
            epi::FProj f{ws, GOUT(args), l};
            epi::EpiRow8<epi::FProj> E{f};
            pg8::gemm_phase<epi::EpiRow8<epi::FProj>, pg8::StaticOrder, true, true>(F.lds + RING_OFF, g, S, E, F.wave);
            { const SOp op[1] = {{(const bf16*)(ws + WS_XB) + (size_t)MP * DM, DM, (const bf16*)(wl + WL_IN), DM}};
              float* out = GOUT(args);
              sgemm_phase<1>(F, bx, op, NPROJ / 16, RowLinear{}, [=](int r, int u, int c, float v, float) { const int col = 16 * u + c, row = MP + r;
                  if (col < 3072) { const int kind = col >> 9, cw = col & 511;
                      if (kind == 0 || kind == 3) v *= C2;
                      else { const size_t oS = kind == 1 ? O_FKS : (kind == 2 ? O_FVS : (kind == 4 ? O_DKS : O_DVS)); out[oS + ((size_t)l * MS + r) * 512 + cw] = v; }
                      ((bf16*)(ws + WS_QA + (size_t)kind * SZ_H))[(size_t)row * 512 + cw] = (bf16)f2bf(v);
                  } else ((bf16*)(ws + WS_G))[(size_t)row * 2048 + (col - 3072)] = (bf16)f2bf(epi::sigm(v)); }); }
            logf_phase(F, args, l);
            SEAM(p0 + 0);
        }
        if (IN(p0 + 1)) { FRESH(); scan_phase(F, args, l); SEAM(p0 + 1); }
        if (IN(p0 + 2)) { FRESH(); prompt_attn_phase((char*)lds + RING_OFF, ws, F.vcu, F.G, F.wave); FRESH(); sample_attn_phase(F, args, l); SEAM(p0 + 2); }
        if (IN(p0 + 3)) { FRESH(); diff_finalize(F, args, l); sample_finalize(F, args, l); SEAM(p0 + 3); }
        if (IN(p0 + 4)) { FRESH();
            pg8::Gemm g{(const bf16*)(ws + WS_OA), (const bf16*)(wl + WL_BA), MP, DM, 512}; pg8::StaticOrder S; S.init(MP, DM, F.G, bx);
            epi::EpiRow8<epi::FGate1> E{epi::FGate1{(const bf16*)(ws + WS_G), (float*)(ws + WS_T1)}};
            pg8::gemm_phase<epi::EpiRow8<epi::FGate1>, pg8::StaticOrder, true, true>(F.lds + RING_OFF, g, S, E, F.wave);
            SEAM(p0 + 4);
        }
        if (IN(p0 + 5)) { FRESH();
            pg8::Gemm g{(const bf16*)(ws + WS_OB), (const bf16*)(wl + WL_BB), MP, DM, 512}; pg8::StaticOrder S; S.init(MP, DM, F.G, bx);
            epi::EpiRow8<epi::FGate2> E{epi::FGate2{(const bf16*)(ws + WS_G), (const float*)(ws + WS_T1), (bf16*)(ws + WS_MG)}};
            pg8::gemm_phase<epi::EpiRow8<epi::FGate2>, pg8::StaticOrder, true, true>(F.lds + RING_OFF, g, S, E, F.wave);
            { const SOp op[2] = {{(const bf16*)(ws + WS_OA) + (size_t)MP * 512, 512, (const bf16*)(wl + WL_BA), 512}, {(const bf16*)(ws + WS_OB) + (size_t)MP * 512, 512, (const bf16*)(wl + WL_BB), 512}};
              sgemm_phase<2>(F, bx, op, DM / 16, RowLinear{}, [=](int r, int u, int c, float v0, float v1) { const int col = 16 * u + c; const size_t row = MP + r; const bf16* G = (const bf16*)(ws + WS_G) + row * 2048;
                  ((bf16*)(ws + WS_MG))[row * DM + col] = (bf16)f2bf(epi::bf2f(G[col]) * v0 + epi::bf2f(G[1024 + col]) * v1); }); }
            SEAM(p0 + 5);
        }
        if (IN(p0 + 6)) { FRESH();
            pg8::Gemm g{(const bf16*)(ws + WS_MG), (const bf16*)(wl + WL_O), MP, DM, DM}; pg8::StaticOrder S; S.init(MP, DM, F.G, bx);
            epi::EpiRow8<epi::FRes> E{epi::FRes{(const float*)(ws + WS_XF), nullptr, (float*)(ws + WS_PRE)}};
            pg8::gemm_phase<epi::EpiRow8<epi::FRes>, pg8::StaticOrder, true, true>(F.lds + RING_OFF, g, S, E, F.wave);
            { const SOp op[1] = {{(const bf16*)(ws + WS_MG) + (size_t)MP * DM, DM, (const bf16*)(wl + WL_O), DM}};
              sgemm_phase<1>(F, bx, op, DM / 16, RowLinear{}, [=](int r, int u, int c, float v, float) { const size_t off = (size_t)(MP + r) * DM + 16 * u + c;
                  ((float*)(ws + WS_PRE))[off] = ALPHA * ((const float*)(ws + WS_XF))[off] + v; }); }
            SEAM(p0 + 6);
        }
        if (IN(p0 + 7)) { FRESH(); ln_phase(F, args, GIN(args, I_L1G) + l * DM, GIN(args, I_L1B) + l * DM, false); SEAM(p0 + 7); }
        if (IN(p0 + 8)) { FRESH();
            pg8::Gemm g{(const bf16*)(ws + WS_PB) + (size_t)l * MPAD * PLE, (const bf16*)(wl + WL_PPW), MP, DM, PLE}; pg8::StaticOrder S; S.init(MP, DM, F.G, bx);
            epi::EpiRow8<epi::FStoreF32> E{epi::FStoreF32{(float*)(ws + WS_PPO)}};
            pg8::gemm_phase<epi::EpiRow8<epi::FStoreF32>, pg8::StaticOrder, true, true>(F.lds + RING_OFF, g, S, E, F.wave);
            SEAM(p0 + 8);
        }
        if (IN(p0 + 9)) { FRESH();
            { pg8::Gemm g{(const bf16*)(ws + WS_XB), (const bf16*)(wl + WL_GU), MP, NGU, DM}; pg8::StaticOrder S; S.init(MP, NGU, F.G, bx);
              epi::EpiSwiGLU E{(bf16*)(ws + WS_HB), DFF};
              pg8::gemm_phase<epi::EpiSwiGLU, pg8::StaticOrder, true, true>(F.lds + RING_OFF, g, S, E, F.wave); }
            { pg8::Gemm g{(const bf16*)(ws + WS_XB), (const bf16*)(wl + WL_PG), MP, DM, DM}; pg8::StaticOrder S; S.init(MP, DM, F.G, bx);
              epi::EpiRow8<epi::FPleGate> E{epi::FPleGate{(const float*)(ws + WS_PPO), (float*)(ws + WS_PLE)}};
              pg8::gemm_phase<epi::EpiRow8<epi::FPleGate>, pg8::StaticOrder, true, true>(F.lds + RING_OFF, g, S, E, F.wave); }
            { const bf16* xs = (const bf16*)(ws + WS_XB) + (size_t)MP * DM;
              { const SOp op[2] = {{xs, DM, (const bf16*)(wl + WL_GU), DM}, {xs, DM, (const bf16*)(wl + WL_GU), DM}};
                sgemm_phase<2>(F, bx, op, DFF / 16, RowGateUp{}, [=](int r, int u, int c, float g, float up) { ((bf16*)(ws + WS_HB))[(size_t)(MP + r) * DFF + 16 * u + c] = (bf16)f2bf(g * epi::sigm(g) * up); }); }
              { const SOp op[2] = {{xs, DM, (const bf16*)(wl + WL_PG), DM}, {(const bf16*)(ws + WS_PB) + ((size_t)l * MPAD + MP) * PLE, PLE, (const bf16*)(wl + WL_PPW), PLE}};
                sgemm_phase<2>(F, bx, op, DM / 16, RowLinear{}, [=](int r, int u, int c, float v0, float v1) { ((float*)(ws + WS_PLE))[(size_t)(MP + r) * DM + 16 * u + c] = epi::sigm(v0) * v1; }); } }
            SEAM(p0 + 9);
        }
        if (IN(p0 + 10)) { FRESH();
            pg8::Gemm g{(const bf16*)(ws + WS_HB), (const bf16*)(wl + WL_D), MP, DM, DFF}; pg8::StaticOrder S; S.init(MP, DM, F.G, bx);
            epi::EpiRow8<epi::FRes> E{epi::FRes{(const float*)(ws + WS_XF), (const float*)(ws + WS_PLE), (float*)(ws + WS_PRE)}};
            pg8::gemm_phase<epi::EpiRow8<epi::FRes>, pg8::StaticOrder, true, true>(F.lds + RING_OFF, g, S, E, F.wave);
            { const SOp op[1] = {{(const bf16*)(ws + WS_HB) + (size_t)MP * DFF, DFF, (const bf16*)(wl + WL_D), DFF}};
              sgemm_phase<1>(F, bx, op, DM / 16, RowLinear{}, [=](int r, int u, int c, float v, float) { const size_t off = (size_t)(MP + r) * DM + 16 * u + c;
                  ((float*)(ws + WS_PRE))[off] = ALPHA * ((const float*)(ws + WS_XF))[off] + v + ((const float*)(ws + WS_PLE))[off]; }); }
            SEAM(p0 + 10);
        }
        if (IN(p0 + 11)) { FRESH(); ln_phase(F, args, GIN(args, I_L2G) + l * DM, GIN(args, I_L2B) + l * DM, l == DEPTH - 1); SEAM(p0 + 11); }
    }
#undef IN
#undef SEAM
#undef args
}

extern "C" void kernel_launch(void* const* d_in, const int* in_sizes, int n_in, void* d_out, int out_size, void* d_ws, size_t ws_size, hipStream_t stream) {
    static int grid = 0;
    if (grid == 0) {
        if (n_in != N_IN || (size_t)out_size != O_END || ws_size < WS_END2) { fprintf(stderr, "kernel_launch: unexpected shapes: n_in %d out %d ws %zu (need %zu)\n", n_in, out_size, ws_size, (size_t)WS_END2); grid = -1; return; }
        int dev = 0, cus = 0, per_cu = 0;
        if (hipGetDevice(&dev) != hipSuccess || hipDeviceGetAttribute(&cus, hipDeviceAttributeMultiprocessorCount, dev) != hipSuccess) { grid = -1; return; }
        if (hipFuncSetAttribute((const void*)mk_fwd, hipFuncAttributeMaxDynamicSharedMemorySize, LDS_BYTES) != hipSuccess) { fprintf(stderr, "kernel_launch: hipFuncSetAttribute failed\n"); grid = -1; return; }
        if (hipOccupancyMaxActiveBlocksPerMultiprocessor(&per_cu, (const void*)mk_fwd, NWAVES * 64, LDS_BYTES) != hipSuccess || per_cu < 1) fprintf(stderr, "kernel_launch: occupancy query says %d\n", per_cu);
        (void)hipGetLastError();
        grid = cus;
    }
    if (grid < 0) return;
    if (hipMemsetAsync((char*)d_ws + WS_CTL, 0, CTL_ZERO_BYTES, stream) != hipSuccess) return;
    Args a{};
    for (int i = 0; i < N_IN; ++i) a.in[i] = (const float*)d_in[i];
    a.out = (float*)d_out; a.ws = (unsigned char*)d_ws;
#if MK_ATTN_NAIVE
    NaiveArgs na{};
    for (int i = 0; i < N_IN; ++i) na.in[i] = (const float*)d_in[i];
    na.ws = (unsigned char*)d_ws;
    for (int ph = 0; ph < NPHASES; ++ph) {
        const int l = (ph - 1) / NPH, p = (ph - 1) % NPH;
        if (ph > 0 && p == 2) {
            na.layer = l;
#if MK_ATTN_NAIVE >= 2
            na.sample = 0; na.mode = 0; hipLaunchKernelGGL(naive_attn<64>, dim3(SEQ / 64, 8, NB), dim3(64), 0, stream, na);
            na.sample = 0; na.mode = 1; hipLaunchKernelGGL(naive_attn<128>, dim3(SEQ / 64, 8, NB), dim3(64), 0, stream, na);
#else
            a.ph_lo = ph; a.ph_hi = ph + 1; hipLaunchKernelGGL(mk_fwd, dim3(grid), dim3(NWAVES * 64), LDS_BYTES, stream, a);
#endif
#if MK_ATTN_NAIVE >= 3
            na.sample = 1; na.mode = 0; hipLaunchKernelGGL(naive_attn<64>, dim3(1, 8, SBATCH), dim3(64), 0, stream, na);
            na.sample = 1; na.mode = 1; hipLaunchKernelGGL(naive_attn<128>, dim3(1, 8, SBATCH), dim3(64), 0, stream, na);
#endif
            continue;
        }
        a.ph_lo = ph; a.ph_hi = ph + 1;
        hipLaunchKernelGGL(mk_fwd, dim3(grid), dim3(NWAVES * 64), LDS_BYTES, stream, a);
    }
#else
    a.ph_lo = 0; a.ph_hi = NPHASES;
    hipLaunchKernelGGL(mk_fwd, dim3(grid), dim3(NWAVES * 64), LDS_BYTES, stream, a);
#endif
    const hipError_t le = hipPeekAtLastError();
    if (le != hipSuccess) fprintf(stderr, "kernel_launch: launch failed: %s\n", hipGetErrorName(le));
}
```
